# Optimizing an MI355X kernel written in HIP

```python
import math
import jax, jax.numpy as jnp
from jax import lax
import numpy as np

D_MODEL = 1024
BATCH = 4
SEQ = 8192
DEPTH = 1

CTX_LEN = 256
GRID_W = 64
GDN_HEADS = 8
GDN_DK = 128
GDN_DV = 128
GDN_CONV = 3
ML_HEADS = 4
ML_DK = 128
ML_DV = 256
CHUNK = 64
GATE_CAP = 15.0
D_FF = 2816
FFN_CONV = 3
N_MOD = 6
EPS = 1e-6

GDN_QK = GDN_HEADS * GDN_DK
GDN_V = GDN_HEADS * GDN_DV
ML_QK = ML_HEADS * ML_DK
ML_V = ML_HEADS * ML_DV
STATE_SIZES = (2 * GDN_QK + GDN_V, 2 * GDN_HEADS, 2 * GDN_HEADS, ML_QK, ML_QK, ML_V, 2 * ML_HEADS, 2 * ML_HEADS)
OUT_SIZES = (GDN_V, ML_V, D_MODEL, D_MODEL)
N_STATE_COLS = sum(STATE_SIZES)
N_IN_COLS = N_STATE_COLS + sum(OUT_SIZES)

kernel_name = 'hybrid_gdn_mlstm_convffn_ctx_prefix'


def rms_norm(x, w):
    xf = x.astype(jnp.float32)
    y = xf * lax.rsqrt(jnp.mean(xf * xf, axis=-1, keepdims=True) + EPS)
    return (y * w.astype(jnp.float32)).astype(x.dtype)


def l2_normalize(x):
    xf = x.astype(jnp.float32)
    return xf * lax.rsqrt(jnp.sum(xf * xf, axis=-1, keepdims=True) + EPS)


def soft_cap(x):
    return GATE_CAP * jnp.tanh(x / GATE_CAP)


def split_cols(z, sizes):
    return jnp.split(z, [int(s) for s in np.cumsum(sizes)[:-1]], axis=-1)


def to_heads(a, n_heads):
    b, t, _ = a.shape
    return a.reshape(b, t, n_heads, -1).transpose(0, 2, 1, 3)


def dir_heads(a, n_heads):
    b, t, _ = a.shape
    return a.reshape(b, t, 2, n_heads).transpose(2, 0, 3, 1)


def flip_t(a):
    return jnp.flip(a, axis=2)


def dwconv_seq(x, w):
    k = w.shape[0]
    return lax.conv_general_dilated(x, w[:, None, :], window_strides=(1,), padding=[(k // 2, k // 2)],
                                    dimension_numbers=('NWC', 'WIO', 'NWC'), feature_group_count=x.shape[-1])


def dwconv_grid(x, w):
    b, t, ch = x.shape
    rows = t // GRID_W
    kh, kw = w.shape[0], w.shape[1]
    y = lax.conv_general_dilated(x.reshape(b, rows, GRID_W, ch), w[:, :, None, :], window_strides=(1, 1),
                                 padding=[(kh // 2, kh // 2), (kw // 2, kw // 2)],
                                 dimension_numbers=('NHWC', 'HWIO', 'NHWC'), feature_group_count=ch)
    return y.reshape(b, t, ch)


def gdn_chunked(q, k, v, g, beta, s0, with_output):
    f32 = jnp.float32
    b, h, t, dk = q.shape
    dv = v.shape[-1]
    n = t // CHUNK
    k = k.astype(f32).reshape(b, h, n, CHUNK, dk)
    v = v.astype(f32).reshape(b, h, n, CHUNK, dv)
    beta = beta.astype(f32).reshape(b, h, n, CHUNK)
    gc = jnp.cumsum(g.astype(f32).reshape(b, h, n, CHUNK), axis=-1)
    lower = jnp.tril(jnp.ones((CHUNK, CHUNK), dtype=bool))
    decay = jnp.exp(jnp.where(lower, gc[..., :, None] - gc[..., None, :], -jnp.inf))
    kb = k * beta[..., None]
    a_strict = jnp.einsum('bhnld,bhnsd->bhnls', kb, k) * decay
    rhs = jnp.concatenate([v * beta[..., None], kb * jnp.exp(gc)[..., None]], axis=-1)
    sol = lax.linalg.triangular_solve(a_strict, rhs, left_side=True, lower=True, unit_diagonal=True)
    u, w = sol[..., :dv], sol[..., dv:]
    k_tail = k * jnp.exp(gc[..., -1:] - gc)[..., None]
    g_tot = jnp.exp(gc[..., -1])
    xs = [u, w, k_tail, g_tot]
    if with_output:
        q = q.astype(f32).reshape(b, h, n, CHUNK, dk) * (dk ** -0.5)
        attn = jnp.einsum('bhnld,bhnsd->bhnls', q, k) * decay
        xs += [q * jnp.exp(gc)[..., None], attn]
    xs = tuple(jnp.moveaxis(a, 2, 0) for a in xs)

    def step(s, xc):
        u_n, w_n, kt_n, gt_n = xc[:4]
        v_new = u_n - jnp.einsum('bhld,bhde->bhle', w_n, s)
        s_next = s * gt_n[..., None, None] + jnp.einsum('bhld,bhle->bhde', kt_n, v_new)
        if not with_output:
            return s_next, None
        qd_n, at_n = xc[4:]
        o = jnp.einsum('bhld,bhde->bhle', qd_n, s) + jnp.einsum('bhls,bhse->bhle', at_n, v_new)
        return s_next, o

    s_fin, o = lax.scan(step, s0, xs)
    if with_output:
        o = jnp.moveaxis(o, 0, 2).reshape(b, h, t, dv)
    return o, s_fin


def mlstm_chunked(q, k, v, ig, lf, state, with_output):
    f32 = jnp.float32
    b, h, t, dk = q.shape
    dv = v.shape[-1]
    n = t // CHUNK
    k = k.astype(f32).reshape(b, h, n, CHUNK, dk)
    v = v.astype(f32).reshape(b, h, n, CHUNK, dv)
    ig = ig.astype(f32).reshape(b, h, n, CHUNK)
    bc = jnp.cumsum(lf.astype(f32).reshape(b, h, n, CHUNK), axis=-1)
    b_last = bc[..., -1]
    tail = b_last[..., None] - bc + ig
    tail_max = jnp.max(tail, axis=-1)
    xs = [k, v, b_last, tail, tail_max]
    if with_output:
        q = q.astype(f32).reshape(b, h, n, CHUNK, dk) * (dk ** -0.5)
        lower = jnp.tril(jnp.ones((CHUNK, CHUNK), dtype=bool))
        dmat = jnp.where(lower, bc[..., :, None] - bc[..., None, :] + ig[..., None, :], -jnp.inf)
        qk = jnp.einsum('bhnld,bhnsd->bhnls', q, k)
        xs += [q, bc, dmat, jnp.max(dmat, axis=-1), qk]
    xs = tuple(jnp.moveaxis(a, 2, 0) for a in xs)

    def step(carry, xc):
        c_st, n_st, m = carry
        k_n, v_n, bl_n, tl_n, tm_n = xc[:5]
        m_new = jnp.maximum(bl_n + m, tm_n)
        wt = jnp.exp(tl_n - m_new[..., None])
        dec = jnp.exp(bl_n + m - m_new)
        c_next = dec[..., None, None] * c_st + jnp.einsum('bhld,bhle->bhde', k_n * wt[..., None], v_n)
        n_next = dec[..., None] * n_st + jnp.einsum('bhl,bhld->bhd', wt, k_n)
        if not with_output:
            return (c_next, n_next, m_new), None
        q_n, b_n, d_n, dm_n, qk_n = xc[5:]
        m_t = jnp.maximum(b_n + m[..., None], dm_n)
        inter = jnp.exp(b_n + m[..., None] - m_t)
        p = qk_n * jnp.exp(d_n - m_t[..., None])
        num = inter[..., None] * jnp.einsum('bhld,bhde->bhle', q_n, c_st) + jnp.einsum('bhls,bhse->bhle', p, v_n)
        den = inter * jnp.einsum('bhld,bhd->bhl', q_n, n_st) + jnp.sum(p, axis=-1)
        out = num / jnp.maximum(jnp.abs(den), jnp.exp(-m_t))[..., None]
        return (c_next, n_next, m_new), out

    fin, out = lax.scan(step, state, xs)
    if with_output:
        out = jnp.moveaxis(out, 0, 2).reshape(b, h, t, dv)
    return out, fin


def token_mixer(hn, states, with_output, w_in, gdn_conv, gdn_a_log, gdn_dt_bias, gdn_norm_w,
                ml_igate_b, ml_fgate_b, ml_norm_w, w_branch_gdn, w_branch_ml, w_out):
    bsz, t, _ = hn.shape
    s_gdn_f, s_gdn_b, s_ml_f, s_ml_b = states
    zs = hn @ w_in[:, :N_STATE_COLS]
    gdn_qkv, gdn_a, gdn_b, ml_q, ml_k, ml_v, ml_i, ml_f = split_cols(zs, STATE_SIZES)
    gdn_qkv = jax.nn.silu(dwconv_seq(gdn_qkv, gdn_conv))
    gq, gk, gv = split_cols(gdn_qkv, (GDN_QK, GDN_QK, GDN_V))
    gq = l2_normalize(to_heads(gq, GDN_HEADS))
    gk = l2_normalize(to_heads(gk, GDN_HEADS))
    gv = to_heads(gv, GDN_HEADS)
    a = dir_heads(gdn_a, GDN_HEADS).astype(jnp.float32)
    log_decay = -jnp.exp(gdn_a_log.astype(jnp.float32))[:, None, :, None] * jax.nn.softplus(
        a + gdn_dt_bias.astype(jnp.float32)[:, None, :, None])
    beta = jax.nn.sigmoid(dir_heads(gdn_b, GDN_HEADS))
    o_f, s_gdn_f = gdn_chunked(gq, gk, gv, log_decay[0], beta[0], s_gdn_f, with_output)
    o_b, s_gdn_b = gdn_chunked(flip_t(gq), flip_t(gk), flip_t(gv), flip_t(log_decay[1]), flip_t(beta[1]),
                               s_gdn_b, with_output)
    mq = to_heads(ml_q, ML_HEADS)
    mk = to_heads(ml_k, ML_HEADS)
    mv = to_heads(ml_v, ML_HEADS)
    ig = soft_cap(dir_heads(ml_i, ML_HEADS).astype(jnp.float32) + ml_igate_b.astype(jnp.float32)[:, None, :, None])
    lf = jax.nn.log_sigmoid(soft_cap(dir_heads(ml_f, ML_HEADS).astype(jnp.float32)
                                     + ml_fgate_b.astype(jnp.float32)[:, None, :, None]))
    h_f, s_ml_f = mlstm_chunked(mq, mk, mv, ig[0], lf[0], s_ml_f, with_output)
    h_b, s_ml_b = mlstm_chunked(flip_t(mq), flip_t(mk), flip_t(mv), flip_t(ig[1]), flip_t(lf[1]),
                                s_ml_b, with_output)
    new_states = (s_gdn_f, s_gdn_b, s_ml_f, s_ml_b)
    if not with_output:
        return None, new_states
    zo = hn @ w_in[:, N_STATE_COLS:]
    gdn_z, ml_o, gate_gdn, gate_ml = split_cols(zo, OUT_SIZES)
    o = (o_f + flip_t(o_b)).astype(hn.dtype).transpose(0, 2, 1, 3)
    o = rms_norm(o, gdn_norm_w) * jax.nn.silu(gdn_z.reshape(bsz, t, GDN_HEADS, GDN_DV))
    y_gdn = o.reshape(bsz, t, GDN_V) @ w_branch_gdn
    hm = (h_f + flip_t(h_b)).astype(hn.dtype).transpose(0, 2, 1, 3)
    hm = rms_norm(hm, ml_norm_w) * jax.nn.sigmoid(ml_o.reshape(bsz, t, ML_HEADS, ML_DV))
    y_ml = hm.reshape(bsz, t, ML_V) @ w_branch_ml
    merged = jax.nn.sigmoid(gate_gdn) * y_gdn + jax.nn.sigmoid(gate_ml) * y_ml
    return merged @ w_out, new_states


def conv_ffn(hn, w_up, conv_w, w_down, on_grid):
    u = hn @ w_up
    u = dwconv_grid(u, conv_w) if on_grid else dwconv_seq(u, conv_w[FFN_CONV // 2])
    gate, val = u[..., :D_FF], u[..., D_FF:]
    return (jax.nn.silu(gate) * val) @ w_down


def setup_inputs(seed: int = 0) -> dict:
    key = jax.random.key(seed)
    ks = jax.random.split(key, 32)
    f32 = jnp.float32

    def nrm(k, shape, scale):
        return jax.random.normal(k, shape, f32) * scale

    L, D = DEPTH, D_MODEL
    dt = jnp.exp(jax.random.uniform(ks[10], (L, 2, GDN_HEADS), f32, math.log(1e-3), math.log(0.1)))
    return {
        'x': nrm(ks[0], (BATCH, SEQ, D), 1.0),
        'c': nrm(ks[1], (BATCH, D), 1.0),
        'ctx': nrm(ks[2], (BATCH, CTX_LEN, D), 1.0),
        'c_ctx': nrm(ks[3], (D,), 1.0),
        'w_ada': nrm(ks[4], (L, D, N_MOD * D), 0.5 * D ** -0.5),
        'b_ada': nrm(ks[5], (L, N_MOD * D), 0.02),
        'norm1_w': 1.0 + nrm(ks[6], (L, D), 0.02),
        'w_in': nrm(ks[7], (L, D, N_IN_COLS), D ** -0.5),
        'gdn_conv': nrm(ks[8], (L, GDN_CONV, 2 * GDN_QK + GDN_V), GDN_CONV ** -0.5),
        'gdn_a_log': jnp.log(jax.random.uniform(ks[9], (L, 2, GDN_HEADS), f32, 1.0, 16.0)),
        'gdn_dt_bias': dt + jnp.log(-jnp.expm1(-dt)),
        'gdn_norm_w': 1.0 + nrm(ks[11], (L, GDN_DV), 0.02),
        'ml_igate_b': nrm(ks[12], (L, 2, ML_HEADS), 0.1),
        'ml_fgate_b': 3.0 + nrm(ks[13], (L, 2, ML_HEADS), 0.5),
        'ml_norm_w': 1.0 + nrm(ks[14], (L, ML_HEADS, ML_DV), 0.02),
        'w_branch_gdn': nrm(ks[15], (L, GDN_V, D), GDN_V ** -0.5),
        'w_branch_ml': nrm(ks[16], (L, ML_V, D), ML_V ** -0.5),
        'w_out': nrm(ks[17], (L, D, D), D ** -0.5),
        'norm2_w': 1.0 + nrm(ks[18], (L, D), 0.02),
        'w_up': nrm(ks[19], (L, D, 2 * D_FF), D ** -0.5),
        'ffn_conv': nrm(ks[20], (L, FFN_CONV, FFN_CONV, 2 * D_FF), 1.0 / FFN_CONV),
        'w_down': nrm(ks[21], (L, D_FF, D), D_FF ** -0.5),
        'norm_out_w': 1.0 + nrm(ks[22], (D,), 0.02),
    }


def reference(x, c, ctx, c_ctx, w_ada, b_ada, norm1_w, w_in, gdn_conv, gdn_a_log, gdn_dt_bias, gdn_norm_w,
              ml_igate_b, ml_fgate_b, ml_norm_w, w_branch_gdn, w_branch_ml, w_out, norm2_w, w_up, ffn_conv,
              w_down, norm_out_w):
    f32 = jnp.float32
    bsz = x.shape[0]
    s_gdn0 = jnp.zeros((bsz, GDN_HEADS, GDN_DK, GDN_DV), f32)
    s_ml0 = (jnp.zeros((bsz, ML_HEADS, ML_DK, ML_DV), f32), jnp.zeros((bsz, ML_HEADS, ML_DK), f32),
             jnp.zeros((bsz, ML_HEADS), f32))
    zero_states = (s_gdn0, s_gdn0, s_ml0, s_ml0)
    for l in range(DEPTH):
        last = l == DEPTH - 1
        mix_w = (w_in[l], gdn_conv[l], gdn_a_log[l], gdn_dt_bias[l], gdn_norm_w[l], ml_igate_b[l],
                 ml_fgate_b[l], ml_norm_w[l], w_branch_gdn[l], w_branch_ml[l], w_out[l])
        mod_x = (jax.nn.silu(c) @ w_ada[l] + b_ada[l]).reshape(bsz, N_MOD, 1, D_MODEL)
        mod_c = (jax.nn.silu(c_ctx) @ w_ada[l] + b_ada[l]).reshape(N_MOD, D_MODEL)
        hc = rms_norm(ctx, norm1_w[l]) * (1.0 + mod_c[1]) + mod_c[0]
        ctx_mix, ctx_states = token_mixer(hc, zero_states, not last, *mix_w)
        hx = rms_norm(x, norm1_w[l]) * (1.0 + mod_x[:, 1]) + mod_x[:, 0]
        x_mix, _ = token_mixer(hx, ctx_states, True, *mix_w)
        x = x + mod_x[:, 2] * x_mix
        hx = rms_norm(x, norm2_w[l]) * (1.0 + mod_x[:, 4]) + mod_x[:, 3]
        x = x + mod_x[:, 5] * conv_ffn(hx, w_up[l], ffn_conv[l], w_down[l], True)
        if not last:
            ctx = ctx + mod_c[2] * ctx_mix
            hc = rms_norm(ctx, norm2_w[l]) * (1.0 + mod_c[4]) + mod_c[3]
            ctx = ctx + mod_c[5] * conv_ffn(hc, w_up[l], ffn_conv[l], w_down[l], False)
    return rms_norm(x, norm_out_w)
```

```cpp
#include <hip/hip_runtime.h>
#include <hip/hip_cooperative_groups.h>
#include <cstdint>
#include <cstdio>

namespace pg8 {
#define PG8_LAS __attribute__((address_space(3)))
typedef unsigned short bf16_t;
typedef short bf16x8 __attribute__((ext_vector_type(8)));
typedef float f32x4 __attribute__((ext_vector_type(4)));
typedef unsigned u32x4 __attribute__((ext_vector_type(4)));
constexpr int BM = 256, BK = 64, HALF = 128, HTB = HALF * BK * 2  , STAGE_BYTES = 8 * HTB, NXCD = 8, WGM = 8;

__host__ __device__ __forceinline__ int lds_byte(int r, int c) { const int st = (r >> 4) * 2 + (c >> 5), rr = r & 15, cc = c & 31, ob = rr * 64 + cc * 2; return st * 1024 + (ob ^ (((ob >> 9) & 1) << 5)); }
__host__ __device__ __forceinline__ void stage_rc(int b, int& R, int& C) { const int st = b / 1024, sb = b % 1024, swz = sb ^ (((sb >> 9) & 1) << 5); R = (st >> 1) * 16 + swz / 64; C = (st & 1) * 32 + (swz % 64) / 2; }
__host__ __device__ __forceinline__ int perm32(int rho) { const int n = rho >> 4, i = rho & 15; return 8 * (i >> 2) + 4 * n + (i & 3); }

struct Unit { int pm, pn; };
struct Gemm { const bf16_t* A; const bf16_t* Bt; int M, N, K; };

struct StaticOrder {
    int nM, nN, nwg, G, c;
    __host__ __device__ void init(int M, int N, int G_, int c_) { nM = M / BM; nN = N / BM; nwg = nM * nN; G = G_; c = c_; }
    __host__ __device__ bool next(int i, Unit& u) const {
        const long L = (long)i * G + c; if (L >= nwg) return false;
        int wgid = (int)L; { const int q = nwg / NXCD, r = nwg % NXCD, xcd = wgid % NXCD, off = wgid / NXCD; wgid = (xcd < r ? xcd * (q + 1) : r * (q + 1) + (xcd - r) * q) + off; }
        const int nig = WGM * nN, gid = wgid / nig, fm = gid * WGM, gsz = (nM - fm) < WGM ? (nM - fm) : WGM;
        u.pm = fm + ((wgid % nig) % gsz); u.pn = (wgid % nig) / gsz; return true;
    }
    __device__ __forceinline__ void a_ready(const Unit&) const {}
    __device__ __forceinline__ void done(const Unit&) const {}
};

__device__ __forceinline__ unsigned cvt_pk_bf16(float lo, float hi) { unsigned r; asm volatile("v_cvt_pk_bf16_f32 %0, %1, %2" : "=v"(r) : "v"(lo), "v"(hi)); return r; }
typedef float f32x2 __attribute__((ext_vector_type(2)));

template <class Epi, class Sched, bool ALIGN_EPI = false, bool SP2 = false>
__device__ __forceinline__ void gemm_phase(PG8_LAS unsigned char* lds, const Gemm g, const Sched& S, const Epi& E) {
    const int tid = threadIdx.x, wid = __builtin_amdgcn_readfirstlane(tid >> 6), lane = tid & 63, wr = wid >> 2, wc = wid & 3, fr = lane & 15, fq = lane >> 4;
    const int K = g.K, nt = K / BK;
    unsigned voffA[2], voffB[2];
#pragma unroll
    for (int i = 0; i < 2; ++i) { int R, C; stage_rc(tid * 16 + i * 8192, R, C); const int Rb = Epi::PERM ? ((R & ~31) + perm32(R & 31)) : R;
        voffA[i] = (unsigned)(R * K + C) * 2u; voffB[i] = (unsigned)(Rb * K + C) * 2u; }
    const size_t kstep = (size_t)(BK * 2);
    const size_t hstep = (size_t)HALF * K * 2;
    const size_t tstep = 2 * hstep;
    const unsigned ldsw = (unsigned)wid * 1024u;
    const int aoff = lds_byte(wr * 64 + fr, fq * 8), boff = lds_byte(wc * 32 + fr, fq * 8);
#define PG8_SA(b, h) (((b) * 2 + (h)) * HTB)
#define PG8_SB(b, h) ((4 + (b) * 2 + (h)) * HTB)
#define PG8_STAGE(bufoff, gbase, voff) do { _Pragma("unroll") for (int _i = 0; _i < 2; ++_i) \
        __builtin_amdgcn_global_load_lds((const unsigned*)((const char*)(gbase) + (voff)[_i]), (PG8_LAS unsigned*)(lds + (bufoff) + ldsw + _i * 8192), 16, 0, 0); } while (0)
#define PG8_LDA(dst, b, h) do { _Pragma("unroll") for (int m = 0; m < 4; ++m) _Pragma("unroll") for (int k = 0; k < 2; ++k) dst[m][k] = *(const PG8_LAS bf16x8*)(lds + PG8_SA(b, h) + aoff + m * 2048 + k * 1024); } while (0)
#define PG8_LDB(dst, b, h) do { _Pragma("unroll") for (int n = 0; n < 2; ++n) _Pragma("unroll") for (int k = 0; k < 2; ++k) dst[n][k] = *(const PG8_LAS bf16x8*)(lds + PG8_SB(b, h) + boff + n * 2048 + k * 1024); } while (0)
#define PG8_MMA(ai, bj, At, Bt) do { __builtin_amdgcn_s_setprio(1); _Pragma("unroll") for (int m = 0; m < 4; ++m) _Pragma("unroll") for (int n = 0; n < 2; ++n) _Pragma("unroll") for (int k = 0; k < 2; ++k) \
        acc[ai][bj][m][n] = __builtin_amdgcn_mfma_f32_16x16x32_bf16(Bt[n][k], At[m][k], acc[ai][bj][m][n], 0, 0, 0); __builtin_amdgcn_s_setprio(0); } while (0)
#define PG8_WAIT_V(n) asm volatile("s_waitcnt vmcnt(" #n ")" ::: "memory")
#define PG8_WAIT_L(n) asm volatile("s_waitcnt lgkmcnt(" #n ")" ::: "memory")
#define PG8_BAR __builtin_amdgcn_s_barrier()
#define PG8_SCHED __builtin_amdgcn_sched_barrier(0)
    Unit cur, nxt; int ui = 0;
    if (!S.next(0, cur)) return;
    f32x4 acc[2][2][4][2];
#pragma unroll
    for (int a = 0; a < 2; ++a)
#pragma unroll
        for (int b = 0; b < 2; ++b)
#pragma unroll
            for (int m = 0; m < 4; ++m)
#pragma unroll
                for (int n = 0; n < 2; ++n) acc[a][b][m][n] = (f32x4){0.f, 0.f, 0.f, 0.f};
    bf16x8 At[4][2], B0[2][2], B1[2][2];
    const char* cA = (const char*)g.A + (size_t)cur.pm * tstep; const char* cB = (const char*)g.Bt + (size_t)cur.pn * tstep;
    S.a_ready(cur);
    if constexpr (SP2) {
        PG8_STAGE(PG8_SB(0, 0), cB, voffB); PG8_STAGE(PG8_SB(0, 1), cB + hstep, voffB); PG8_STAGE(PG8_SA(0, 0), cA, voffA); PG8_STAGE(PG8_SA(0, 1), cA + hstep, voffA);
        if (wr == 1) PG8_BAR;
        PG8_WAIT_V(2); PG8_BAR;
        PG8_STAGE(PG8_SB(1, 0), cB + kstep, voffB); PG8_STAGE(PG8_SA(1, 0), cA + kstep, voffA); PG8_STAGE(PG8_SB(1, 1), cB + hstep + kstep, voffB);
        PG8_WAIT_V(6); PG8_BAR;
    } else {
        PG8_STAGE(PG8_SB(0, 0), cB, voffB); PG8_STAGE(PG8_SA(0, 0), cA, voffA); PG8_STAGE(PG8_SB(0, 1), cB + hstep, voffB); PG8_STAGE(PG8_SA(0, 1), cA + hstep, voffA);
        if (wr == 1) PG8_BAR;
        PG8_WAIT_V(4); PG8_BAR;
        PG8_STAGE(PG8_SB(1, 0), cB + kstep, voffB); PG8_STAGE(PG8_SA(1, 0), cA + kstep, voffA); PG8_STAGE(PG8_SB(1, 1), cB + hstep + kstep, voffB);
        PG8_WAIT_V(6); PG8_BAR;
    }
    for (;;) {
        const bool has_next = S.next(ui + 1, nxt);
        const char* nA = has_next ? (const char*)g.A + (size_t)nxt.pm * tstep : cA; const char* nB = has_next ? (const char*)g.Bt + (size_t)nxt.pn * tstep : cB;
        for (int t = 0; t < nt; t += 2) {
            const bool last = (t == nt - 2);
            const char* a1 = cA + (size_t)(t + 1) * kstep;
            const char* a2 = last ? nA : cA + (size_t)(t + 2) * kstep; const char* b2 = last ? nB : cB + (size_t)(t + 2) * kstep;
            const char* a3 = a2 + kstep; const char* b3 = b2 + kstep;
            if (last && has_next) S.a_ready(nxt);
            if constexpr (SP2) {
            PG8_LDB(B0, 0, 0); PG8_LDB(B1, 0, 1); PG8_SCHED; PG8_LDA(At, 0, 0); PG8_STAGE(PG8_SA(1, 1), a1 + hstep, voffA);
            PG8_WAIT_V(8); PG8_WAIT_L(0); PG8_BAR; PG8_MMA(0, 0, At, B0); PG8_MMA(0, 1, At, B1); PG8_BAR; PG8_SCHED;
            PG8_LDA(At, 0, 1); PG8_STAGE(PG8_SB(0, 0), b2, voffB); PG8_STAGE(PG8_SB(0, 1), b2 + hstep, voffB); PG8_STAGE(PG8_SA(0, 0), a2, voffA);
            PG8_WAIT_V(8); PG8_WAIT_L(0); PG8_BAR; PG8_MMA(1, 0, At, B0); PG8_MMA(1, 1, At, B1); PG8_BAR; PG8_SCHED;
            PG8_LDB(B0, 1, 0); PG8_LDB(B1, 1, 1); PG8_SCHED; PG8_LDA(At, 1, 0); PG8_STAGE(PG8_SA(0, 1), a2 + hstep, voffA);
            PG8_WAIT_V(8); PG8_WAIT_L(0); PG8_BAR; PG8_MMA(0, 0, At, B0); PG8_MMA(0, 1, At, B1); PG8_BAR; PG8_SCHED;
            PG8_LDA(At, 1, 1); PG8_STAGE(PG8_SB(1, 0), b3, voffB); PG8_STAGE(PG8_SB(1, 1), b3 + hstep, voffB); PG8_STAGE(PG8_SA(1, 0), a3, voffA);
            PG8_WAIT_V(8); PG8_WAIT_L(0); PG8_BAR; PG8_MMA(1, 0, At, B0); PG8_MMA(1, 1, At, B1); PG8_BAR; PG8_SCHED;
            } else {
            PG8_LDB(B0, 0, 0); PG8_SCHED; PG8_LDA(At, 0, 0); PG8_STAGE(PG8_SA(1, 1), a1 + hstep, voffA);
            PG8_WAIT_L(8); PG8_BAR; PG8_WAIT_L(0); PG8_MMA(0, 0, At, B0); PG8_BAR; PG8_SCHED;
            PG8_LDB(B1, 0, 1); PG8_STAGE(PG8_SB(0, 0), b2, voffB);
            PG8_BAR; PG8_WAIT_L(0); PG8_MMA(0, 1, At, B1); PG8_BAR;
            PG8_LDA(At, 0, 1); PG8_STAGE(PG8_SA(0, 0), a2, voffA);
            PG8_BAR; PG8_WAIT_L(0); PG8_MMA(1, 0, At, B0); PG8_BAR; PG8_SCHED;
            PG8_STAGE(PG8_SB(0, 1), b2 + hstep, voffB);
            PG8_WAIT_V(6); PG8_BAR; PG8_MMA(1, 1, At, B1); PG8_BAR;
            PG8_LDB(B0, 1, 0); PG8_SCHED; PG8_LDA(At, 1, 0); PG8_STAGE(PG8_SA(0, 1), a2 + hstep, voffA);
            PG8_WAIT_L(8); PG8_BAR; PG8_WAIT_L(0); PG8_MMA(0, 0, At, B0); PG8_BAR; PG8_SCHED;
            PG8_LDB(B1, 1, 1); PG8_STAGE(PG8_SB(1, 0), b3, voffB);
            PG8_BAR; PG8_WAIT_L(0); PG8_MMA(0, 1, At, B1); PG8_BAR;
            PG8_LDA(At, 1, 1); PG8_STAGE(PG8_SA(1, 0), a3, voffA);
            PG8_BAR; PG8_WAIT_L(0); PG8_MMA(1, 0, At, B0); PG8_BAR; PG8_SCHED;
            PG8_STAGE(PG8_SB(1, 1), b3 + hstep, voffB);
            PG8_WAIT_V(6); PG8_BAR; PG8_MMA(1, 1, At, B1); PG8_BAR;
            }
        }
        if constexpr (ALIGN_EPI) { if (wr == 0) PG8_BAR; }
        if constexpr (!Epi::AFTER_DRAIN) { E(acc, cur, wr, wc, fr, fq); S.done(cur); }
        if (!has_next) break;
#pragma unroll
        for (int a = 0; a < 2; ++a)
#pragma unroll
            for (int b = 0; b < 2; ++b)
#pragma unroll
                for (int m = 0; m < 4; ++m)
#pragma unroll
                    for (int n = 0; n < 2; ++n) acc[a][b][m][n] = (f32x4){0.f, 0.f, 0.f, 0.f};
        cur = nxt; cA = nA; cB = nB; ++ui;
        if constexpr (ALIGN_EPI) { if (wr == 1) PG8_BAR; }
    }
    PG8_WAIT_V(0);
    if constexpr (!ALIGN_EPI) { if (wr == 0) PG8_BAR; }
    PG8_BAR;
    if constexpr (Epi::AFTER_DRAIN) { E.fused(acc, cur, wr, wc, fr, fq, lds, wid, lane); S.done(cur); }
#undef PG8_SA
#undef PG8_SB
#undef PG8_STAGE
#undef PG8_LDA
#undef PG8_LDB
#undef PG8_MMA
#undef PG8_WAIT_V
#undef PG8_WAIT_L
#undef PG8_BAR
#undef PG8_SCHED
}
}


typedef unsigned short bf16_t;
typedef float f32x4 __attribute__((ext_vector_type(4)));
typedef unsigned u32x4 __attribute__((ext_vector_type(4)));
typedef unsigned u32x2 __attribute__((ext_vector_type(2)));
#define LAS __attribute__((address_space(3)))

constexpr int D = 1024, NB = 4, T = 8192, CT = 256, MX = NB * T, MC = NB * CT, MT = MX + MC;
constexpr int DFF = 2816, NMOD = 6;
constexpr int NIN = 9264, NST = 5168, NSTP = 5376;
constexpr float EPS = 1e-6f, GCAP = 15.0f;
constexpr float QSCALE = 0.08838834764831845f;
constexpr int UPA_N = 2560, UPA_C = 1280, UPB_N = 3072, UPB_C = 1536;

constexpr size_t MiB = 1u << 20;
constexpr size_t WS_CTL = 0, WS_MOD = 1 * MiB, WS_GATES = 2 * MiB, WS_HALO = 11 * MiB, WS_SCAL = 18 * MiB;
constexpr size_t WS_QKV = 30 * MiB, WS_ML = 228 * MiB, WS_HX = 360 * MiB, WS_WINS = 492 * MiB;
constexpr size_t WS_GSC = 18 * MiB, WS_TB = 360 * MiB, WS_ATTN = 426 * MiB, WS_MLS = 503 * MiB;
constexpr size_t WS_HXB = 2 * MiB, WS_WINO = 68 * MiB, WS_WBG = 76 * MiB, WS_WBM = 78 * MiB, WS_WOUT = 80 * MiB, WS_WUP = 82 * MiB, WS_WDOWN = 93 * MiB;
constexpr size_t WS_Z = 110 * MiB, WS_TMP = 366 * MiB, WS_MERGED = 366 * MiB;
constexpr size_t WS_ROWSS = 1 * MiB + 256 * 1024, WS_SHW = 1 * MiB + 512 * 1024;
constexpr size_t WS_HX2 = 2 * MiB, WS_U = 110 * MiB, WS_ACT = 302 * MiB;

constexpr int NWAVES = 8, NTHREADS = 512;
constexpr int LDS_BYTES = 163840;
constexpr int LDS_MISC = 163712;

struct P {
    const float *x, *c, *ctx, *c_ctx, *w_ada, *b_ada, *norm1_w, *w_in, *gdn_conv, *gdn_a_log, *gdn_dt_bias, *gdn_norm_w,
        *ml_igate_b, *ml_fgate_b, *ml_norm_w, *w_bg, *w_bm, *w_out, *norm2_w, *w_up, *ffn_conv, *w_down, *norm_out_w;
    float* out; unsigned char* ws;
};
struct Args { P p; int ph_lo, ph_hi; };

__device__ __forceinline__ float bf2f(bf16_t v) { return __uint_as_float((unsigned)v << 16); }
__device__ __forceinline__ bf16_t f2bf(float f) { unsigned u = __float_as_uint(f); return (bf16_t)((u + 0x7fffu + ((u >> 16) & 1u)) >> 16); }
__device__ __forceinline__ unsigned pk2(float lo, float hi) { return (unsigned)f2bf(lo) | ((unsigned)f2bf(hi) << 16); }
__device__ __forceinline__ float sigmoidf_(float x) { return 1.0f / (1.0f + __expf(-x)); }
__device__ __forceinline__ float siluf_(float x) { return x / (1.0f + __expf(-x)); }
__device__ __forceinline__ float silu_fast(float x) { return x * __builtin_amdgcn_rcpf(1.0f + __expf(-x)); }
__device__ __forceinline__ float softplusf_(float x) { return x > 20.f ? x : log1pf(expf(x)); }
__device__ __forceinline__ float softcapf_(float x) { return GCAP * tanhf(x * (1.0f / GCAP)); }
__device__ __forceinline__ float wave_sum(float v) {
#pragma unroll
    for (int o = 1; o < 64; o <<= 1) v += __shfl_xor(v, o);
    return v;
}
__device__ __forceinline__ int row_modv(int r) { return r < MX ? (r >> 13) : 4; }
__device__ __forceinline__ f32x4 bf4_to_f32(uint2 v) { return (f32x4){__uint_as_float(v.x << 16), __uint_as_float(v.x & 0xffff0000u), __uint_as_float(v.y << 16), __uint_as_float(v.y & 0xffff0000u)}; }

namespace epi {
using pg8::Unit; using pg8::cvt_pk_bf16;
typedef float f32x4 __attribute__((ext_vector_type(4)));
__device__ __forceinline__ u32x4 pack8(const f32x4 a, const f32x4 b) { u32x4 w; w.x = cvt_pk_bf16(a[0], a[1]); w.y = cvt_pk_bf16(a[2], a[3]); w.z = cvt_pk_bf16(b[0], b[1]); w.w = cvt_pk_bf16(b[2], b[3]); return w; }
__device__ __forceinline__ f32x4 silu4(f32x4 v) { return (f32x4){siluf_(v[0]), siluf_(v[1]), siluf_(v[2]), siluf_(v[3])}; }
__device__ __forceinline__ f32x4 sigm4(f32x4 v) { return (f32x4){sigmoidf_(v[0]), sigmoidf_(v[1]), sigmoidf_(v[2]), sigmoidf_(v[3])}; }

struct Zs {
    static constexpr bool PERM = true, AFTER_DRAIN = false;
    bf16_t* qkv; bf16_t* ml; float* gates; bf16_t* halo;
    __device__ __forceinline__ void operator()(const f32x4 (&acc)[2][2][4][2], const Unit& u, int wr, int wc, int fr, int fq) const {
        const int row0 = u.pm * 256 + wr * 64 + fr, c8 = wc * 32 + 8 * fq;
        if (u.pn < 20) {
            bf16_t* pb[2]; int ld2[2]; const int col0 = u.pn * 256 + c8;
#pragma unroll
            for (int bj = 0; bj < 2; ++bj) {
                if (u.pn < 12) { pb[bj] = qkv + (size_t)(2 * u.pn + bj) * MT * 128 + c8; ld2[bj] = 128; }
                else { const int cm = (u.pn - 12) * 256 + bj * 128;
                    if (cm < 1024) { pb[bj] = ml + (size_t)(cm >> 7) * MT * 128 + c8; ld2[bj] = 128; }
                    else { pb[bj] = ml + (size_t)8 * MT * 128 + (size_t)((cm - 1024) >> 8) * MT * 256 + ((cm - 1024) & 255) + c8; ld2[bj] = 256; } } }
#pragma unroll
            for (int ai = 0; ai < 2; ++ai)
#pragma unroll
                for (int m = 0; m < 4; ++m) { const int row = row0 + ai * 128 + m * 16;
#pragma unroll
                    for (int bj = 0; bj < 2; ++bj) { const u32x4 w = pack8(acc[ai][bj][m][0], acc[ai][bj][m][1]);
                        *(u32x4*)(pb[bj] + (size_t)row * ld2[bj]) = w;
                        if (u.pn < 12) {
                            if (m == 0 && fr == 0) *(u32x4*)(halo + ((size_t)(row >> 6) * 2 + 0) * 3072 + col0 + bj * 128) = w;
                            if (m == 3 && fr == 15) *(u32x4*)(halo + ((size_t)(row >> 6) * 2 + 1) * 3072 + col0 + bj * 128) = w; } } }
        } else {
            if (c8 < 48) {
#pragma unroll
                for (int ai = 0; ai < 2; ++ai)
#pragma unroll
                    for (int m = 0; m < 4; ++m) { const int row = row0 + ai * 128 + m * 16; float* g = gates + (size_t)row * 64 + c8;
                        *(f32x4*)g = acc[ai][0][m][0]; *(f32x4*)(g + 4) = acc[ai][0][m][1]; }
            }
        }
    }
};
struct Zo {
    static constexpr bool PERM = true, AFTER_DRAIN = false;
    bf16_t* g2; bf16_t* O; bf16_t* HM; const float* gw; const float* mw; LAS float* scr;
    __device__ __forceinline__ void operator()(const f32x4 (&acc)[2][2][4][2], const Unit& u, int wr, int wc, int fr, int fq) const {
        const int row0 = u.pm * 256 + wr * 64 + fr, c8 = wc * 32 + 8 * fq;
        if (u.pn >= 8) {
            const int col0 = (u.pn - 8) * 256 + c8;
#pragma unroll
            for (int ai = 0; ai < 2; ++ai)
#pragma unroll
                for (int m = 0; m < 4; ++m) { const int row = row0 + ai * 128 + m * 16;
#pragma unroll
                    for (int bj = 0; bj < 2; ++bj) *(u32x4*)(g2 + (size_t)row * 2048 + col0 + bj * 128) = pack8(sigm4(acc[ai][bj][m][0]), sigm4(acc[ai][bj][m][1])); }
            return;
        }
        const bool isg = u.pn < 4; bf16_t* X = isg ? O : HM; const int xc0 = (isg ? u.pn : u.pn - 4) * 256 + c8;
#pragma unroll
        for (int ai = 0; ai < 2; ++ai)
#pragma unroll
            for (int m = 0; m < 4; ++m) { const int rl = ai * 128 + wr * 64 + m * 16 + fr; const bf16_t* xp = X + (size_t)(u.pm * 256 + rl) * 1024 + xc0;
#pragma unroll
                for (int bj = 0; bj < 2; ++bj) { const u32x4 xv = *(const u32x4*)(xp + bj * 128);
                    const f32x4 x0 = bf4_to_f32(make_uint2(xv.x, xv.y)), x1 = bf4_to_f32(make_uint2(xv.z, xv.w));
                    float ss = x0[0] * x0[0] + x0[1] * x0[1] + x0[2] * x0[2] + x0[3] * x0[3] + x1[0] * x1[0] + x1[1] * x1[1] + x1[2] * x1[2] + x1[3] * x1[3];
                    ss += __shfl_xor(ss, 16); ss += __shfl_xor(ss, 32);
                    if (fq == 0) scr[rl * 8 + wc * 2 + bj] = ss; } }
        asm volatile("s_waitcnt lgkmcnt(0)" ::: "memory"); __builtin_amdgcn_s_barrier(); asm volatile("" ::: "memory");
#pragma unroll
        for (int ai = 0; ai < 2; ++ai)
#pragma unroll
            for (int m = 0; m < 4; ++m) { const int rl = ai * 128 + wr * 64 + m * 16 + fr; bf16_t* xp = X + (size_t)(u.pm * 256 + rl) * 1024 + xc0;
                const f32x4 p0 = *(const LAS f32x4*)(scr + rl * 8), p1 = *(const LAS f32x4*)(scr + rl * 8 + 4);
                const float t0 = (p0[0] + p0[2]) + (p1[0] + p1[2]), t1 = (p0[1] + p0[3]) + (p1[1] + p1[3]);
                const float rs0 = isg ? rsqrtf(t0 * (1.0f / 128.f) + EPS) : rsqrtf((t0 + t1) * (1.0f / 256.f) + EPS), rs1 = isg ? rsqrtf(t1 * (1.0f / 128.f) + EPS) : rs0;
#pragma unroll
                for (int bj = 0; bj < 2; ++bj) { const u32x4 xv = *(const u32x4*)(xp + bj * 128);
                    const f32x4 x0 = bf4_to_f32(make_uint2(xv.x, xv.y)), x1 = bf4_to_f32(make_uint2(xv.z, xv.w));
                    const float* wp = isg ? gw + c8 : mw + (u.pn - 4) * 256 + bj * 128 + c8;
                    const f32x4 w0 = *(const f32x4*)wp, w1 = *(const f32x4*)(wp + 4);
                    const float rs = bj ? rs1 : rs0;
                    const f32x4 a0 = isg ? silu4(acc[ai][bj][m][0]) : sigm4(acc[ai][bj][m][0]), a1 = isg ? silu4(acc[ai][bj][m][1]) : sigm4(acc[ai][bj][m][1]);
                    *(u32x4*)(xp + bj * 128) = pack8(x0 * rs * w0 * a0, x1 * rs * w1 * a1); } }
    }
};
struct Br1 {
    static constexpr bool PERM = true, AFTER_DRAIN = false;
    const bf16_t* z; bf16_t* tmp;
    __device__ __forceinline__ void operator()(const f32x4 (&acc)[2][2][4][2], const Unit& u, int wr, int wc, int fr, int fq) const {
        const int row0 = u.pm * 256 + wr * 64 + fr, col0 = u.pn * 256 + wc * 32 + 8 * fq;
#pragma unroll
        for (int ai = 0; ai < 2; ++ai)
#pragma unroll
            for (int m = 0; m < 4; ++m) { const int row = row0 + ai * 128 + m * 16;
#pragma unroll
                for (int bj = 0; bj < 2; ++bj) { const int col = col0 + bj * 128;
                    const uint4 gz = *(const uint4*)(z + (size_t)row * 2048 + col);
                    const f32x4 g0 = bf4_to_f32(make_uint2(gz.x, gz.y)), g1 = bf4_to_f32(make_uint2(gz.z, gz.w));
                    *(u32x4*)(tmp + (size_t)row * D + col) = pack8(g0 * acc[ai][bj][m][0], g1 * acc[ai][bj][m][1]); } }
    }
};
struct Br2 {
    static constexpr bool PERM = true, AFTER_DRAIN = false;
    const bf16_t* z; const bf16_t* tmp; bf16_t* merged;
    __device__ __forceinline__ void operator()(const f32x4 (&acc)[2][2][4][2], const Unit& u, int wr, int wc, int fr, int fq) const {
        const int row0 = u.pm * 256 + wr * 64 + fr, col0 = u.pn * 256 + wc * 32 + 8 * fq;
#pragma unroll
        for (int ai = 0; ai < 2; ++ai)
#pragma unroll
            for (int m = 0; m < 4; ++m) { const int row = row0 + ai * 128 + m * 16;
#pragma unroll
                for (int bj = 0; bj < 2; ++bj) { const int col = col0 + bj * 128;
                    const uint4 gz = *(const uint4*)(z + (size_t)row * 2048 + 1024 + col), tz = *(const uint4*)(tmp + (size_t)row * D + col);
                    const f32x4 g0 = bf4_to_f32(make_uint2(gz.x, gz.y)), g1 = bf4_to_f32(make_uint2(gz.z, gz.w));
                    const f32x4 t0 = bf4_to_f32(make_uint2(tz.x, tz.y)), t1 = bf4_to_f32(make_uint2(tz.z, tz.w));
                    *(u32x4*)(merged + (size_t)row * D + col) = pack8(t0 + g0 * acc[ai][bj][m][0], t1 + g1 * acc[ai][bj][m][1]); } }
    }
};
struct Res {
    static constexpr bool PERM = true, AFTER_DRAIN = false;
    const float* base; const float* mod; int modidx; float* out;
    __device__ __forceinline__ void operator()(const f32x4 (&acc)[2][2][4][2], const Unit& u, int wr, int wc, int fr, int fq) const {
        const int row0 = u.pm * 256 + wr * 64 + fr, col0 = u.pn * 256 + wc * 32 + 8 * fq;
        const float* mrow = mod + ((u.pm * 256) >> 13) * (NMOD * D) + modidx * D;
#pragma unroll
        for (int ai = 0; ai < 2; ++ai)
#pragma unroll
            for (int m = 0; m < 4; ++m) { const int row = row0 + ai * 128 + m * 16;
#pragma unroll
                for (int bj = 0; bj < 2; ++bj) { const int col = col0 + bj * 128;
                    const f32x4 b0 = *(const f32x4*)(base + (size_t)row * D + col), b1 = *(const f32x4*)(base + (size_t)row * D + col + 4);
                    const f32x4 g0 = *(const f32x4*)(mrow + col), g1 = *(const f32x4*)(mrow + col + 4);
                    *(f32x4*)(out + (size_t)row * D + col) = b0 + g0 * acc[ai][bj][m][0]; *(f32x4*)(out + (size_t)row * D + col + 4) = b1 + g1 * acc[ai][bj][m][1]; } }
    }
};
struct ResN {
    static constexpr bool PERM = true, AFTER_DRAIN = false;
    const float* base; const float* mod; float* out; bf16_t* an; const float* nw; float* rowss;
    __device__ __forceinline__ void operator()(const f32x4 (&acc)[2][2][4][2], const Unit& u, int wr, int wc, int fr, int fq) const {
        const int row0 = u.pm * 256 + wr * 64 + fr, col0 = u.pn * 256 + wc * 32 + 8 * fq;
        const float* mb = mod + ((u.pm * 256) >> 13) * (NMOD * D);
#pragma unroll
        for (int ai = 0; ai < 2; ++ai)
#pragma unroll
            for (int m = 0; m < 4; ++m) { const int row = row0 + ai * 128 + m * 16; float ss = 0.f;
#pragma unroll
                for (int bj = 0; bj < 2; ++bj) { const int col = col0 + bj * 128;
                    const f32x4 b0 = *(const f32x4*)(base + (size_t)row * D + col), b1 = *(const f32x4*)(base + (size_t)row * D + col + 4);
                    const f32x4 g0 = *(const f32x4*)(mb + 2 * D + col), g1 = *(const f32x4*)(mb + 2 * D + col + 4);
                    const f32x4 xa = b0 + g0 * acc[ai][bj][m][0], xb = b1 + g1 * acc[ai][bj][m][1];
                    *(f32x4*)(out + (size_t)row * D + col) = xa; *(f32x4*)(out + (size_t)row * D + col + 4) = xb;
                    ss += xa[0] * xa[0] + xa[1] * xa[1] + xa[2] * xa[2] + xa[3] * xa[3] + xb[0] * xb[0] + xb[1] * xb[1] + xb[2] * xb[2] + xb[3] * xb[3];
                    const f32x4 w0 = *(const f32x4*)(nw + col) * (*(const f32x4*)(mb + 4 * D + col) + 1.0f), w1 = *(const f32x4*)(nw + col + 4) * (*(const f32x4*)(mb + 4 * D + col + 4) + 1.0f);
                    *(u32x4*)(an + (size_t)row * D + col) = pack8(xa * w0, xb * w1); }
                ss += __shfl_xor(ss, 16); ss += __shfl_xor(ss, 32);
                if (fq == 0) atomicAdd(rowss + row, ss); }
    }
};
struct Up {
    static constexpr bool PERM = true, AFTER_DRAIN = false;
    bf16_t* u_; int ldu; const float* rowss; const float* shw; int coff;
    __device__ __forceinline__ void operator()(const f32x4 (&acc)[2][2][4][2], const Unit& u, int wr, int wc, int fr, int fq) const {
        const int row0 = u.pm * 256 + wr * 64 + fr, col0 = u.pn * 256 + wc * 32 + 8 * fq;
        const float* sb = shw + ((u.pm * 256) >> 13) * (2 * DFF) + coff + col0;
        f32x4 sh[2][2];
#pragma unroll
        for (int bj = 0; bj < 2; ++bj) { sh[bj][0] = *(const f32x4*)(sb + bj * 128); sh[bj][1] = *(const f32x4*)(sb + bj * 128 + 4); }
#pragma unroll
        for (int ai = 0; ai < 2; ++ai)
#pragma unroll
            for (int m = 0; m < 4; ++m) { const int row = row0 + ai * 128 + m * 16; const float rs = rsqrtf(rowss[row] * (1.0f / D) + EPS);
#pragma unroll
                for (int bj = 0; bj < 2; ++bj) *(u32x4*)(u_ + (size_t)row * ldu + col0 + bj * 128) = pack8(acc[ai][bj][m][0] * rs + sh[bj][0], acc[ai][bj][m][1] * rs + sh[bj][1]); }
    }
};
}

struct MapInS { __device__ int col(int n) const { return n < 3072 ? n : (n < 5120 ? n + 32 : (n < 5152 ? 3072 + (n - 5120) : (n < NST ? n : -1))); }
                __device__ float scale(int n) const { return (n >= 3072 && n < 3584) ? QSCALE : 1.0f; } };
struct MapOff { int off; __device__ int col(int n) const { return off + n; } __device__ float scale(int) const { return 1.0f; } };
struct MapUp { __device__ int col(int n) const { if (n < UPA_N) return n < UPA_C ? n : DFF + (n - UPA_C); const int j = n - UPA_N; return j < UPB_C ? UPA_C + j : DFF + UPA_C + (j - UPB_C); }
               __device__ float scale(int) const { return 1.0f; } };
template <class Map>
__device__ __forceinline__ void wt_item(const float* W, int K, int ldw, int nrows, bf16_t* WT, const Map map, LAS float* scr, int item, int lane) {
    const int nblk = nrows / 64, kb = item / nblk, nb = item % nblk, k0 = 64 * kb, n0 = 64 * nb;
    const int sc = map.col(n0 + lane); const float s = map.scale(n0 + lane);
#pragma unroll
    for (int kk = 0; kk < 64; ++kk) scr[kk * 65 + lane] = sc >= 0 ? W[(size_t)(k0 + kk) * ldw + sc] * s : 0.f;
    asm volatile("s_waitcnt lgkmcnt(0)" ::: "memory");
    const int c = lane & 7;
#pragma unroll
    for (int j = 0; j < 8; ++j) { const int n = (lane >> 3) + 8 * j; const LAS float* q = scr + (8 * c) * 65 + n;
        u32x4 o; o.x = pk2(q[0 * 65], q[1 * 65]); o.y = pk2(q[2 * 65], q[3 * 65]); o.z = pk2(q[4 * 65], q[5 * 65]); o.w = pk2(q[6 * 65], q[7 * 65]);
        *(u32x4*)(WT + (size_t)(n0 + n) * K + k0 + 8 * c) = o; }
    asm volatile("s_waitcnt lgkmcnt(0)" ::: "memory");
}
template <class Map>
__device__ __forceinline__ void wt_convert(const float* W, int K, int ldw, int nrows, bf16_t* WT, const Map map, LAS unsigned char* lds, int gw, int ngw) {
    LAS float* scr = (LAS float*)(lds + (threadIdx.x >> 6) * 16896);
    const int items = (K / 64) * (nrows / 64), lane = threadIdx.x & 63;
    for (int it = gw; it < items; it += ngw) wt_item(W, K, ldw, nrows, WT, map, scr, it, lane);
}

__device__ __forceinline__ void phase_mod(const P& p, int bid, int nblk, float* smem) {
    float* mod = (float*)(p.ws + WS_MOD);
    float* s = smem;
    float* red = smem + 5 * 1024;
    const int tid = threadIdx.x;
    for (int i = tid; i < 5 * 1024; i += NTHREADS) { const int v = i >> 10, k = i & 1023; const float cv = v < 4 ? p.c[v * 1024 + k] : p.c_ctx[k]; s[i] = siluf_(cv); }
    __syncthreads();
    const int cl = tid & 31, sl = tid >> 5;
    for (int item = bid; item < (NMOD * D) / 32; item += nblk) {
        const int col = item * 32 + cl;
        float a[5] = {0.f, 0.f, 0.f, 0.f, 0.f};
#pragma unroll 8
        for (int k = sl * 64; k < (sl + 1) * 64; ++k) {
            const float w = p.w_ada[(size_t)k * (NMOD * D) + col];
#pragma unroll
            for (int v = 0; v < 5; ++v) a[v] += s[v * 1024 + k] * w;
        }
#pragma unroll
        for (int v = 0; v < 5; ++v) red[(sl * 5 + v) * 32 + cl] = a[v];
        __syncthreads();
        if (tid < 160) { const int v = tid >> 5, c2 = tid & 31; float t = 0.f;
#pragma unroll
            for (int q = 0; q < 16; ++q) t += red[(q * 5 + v) * 32 + c2];
            mod[v * (NMOD * D) + item * 32 + c2] = t + p.b_ada[item * 32 + c2]; }
        __syncthreads();
    }
}

__device__ __forceinline__ void phase_shw(const P& p, int bid, int nblk, float* smem) {
    const float* mod = (const float*)(p.ws + WS_MOD); float* shw = (float*)(p.ws + WS_SHW);
    float* sv = smem;
    float* red = smem + 4 * 1024;
    const int tid = threadIdx.x;
    for (int i = tid; i < 4 * 1024; i += NTHREADS) sv[i] = mod[(i >> 10) * (NMOD * D) + 3 * D + (i & 1023)];
    __syncthreads();
    const int cl = tid & 31, sl = tid >> 5; const MapUp mp{};
    for (int item = bid; item < (2 * DFF) / 32; item += nblk) {
        const int sc = mp.col(item * 32 + cl);
        float a[4] = {0.f, 0.f, 0.f, 0.f};
#pragma unroll 32
        for (int k = sl * 64; k < (sl + 1) * 64; ++k) { const float w = p.w_up[(size_t)k * (2 * DFF) + sc];
#pragma unroll
            for (int v = 0; v < 4; ++v) a[v] += sv[v * 1024 + k] * w; }
#pragma unroll
        for (int v = 0; v < 4; ++v) red[(sl * 4 + v) * 32 + cl] = a[v];
        __syncthreads();
        if (tid < 128) { const int v = tid >> 5, c2 = tid & 31; float t = 0.f;
#pragma unroll
            for (int q = 0; q < 16; ++q) t += red[(q * 4 + v) * 32 + c2];
            shw[v * (2 * DFF) + item * 32 + c2] = t; }
        __syncthreads();
    }
}

__device__ __forceinline__ void phase_norm(const P& p, int which, int r0, int r1, bf16_t* dst, int bid, int nblk) {
    const float* mod = (const float*)(p.ws + WS_MOD);
    const int lane = threadIdx.x & 63, wv = threadIdx.x >> 6, nwv = blockDim.x >> 6, gwv = bid * nwv + wv, ngw = nblk * nwv;
    const float* w = which == 1 ? p.norm1_w : p.norm2_w;
    f32x4 fa[4], fb[4]; int cur = -1;
    for (int rb = r0 + 4 * gwv; rb < r1; rb += 4 * ngw) {
        f32x4 v[4][4]; float ss[4] = {0.f, 0.f, 0.f, 0.f};
#pragma unroll
        for (int q = 0; q < 4; ++q) { const int r = (rb + q < r1) ? rb + q : rb;
            const float* src = which == 1 ? (r < MX ? p.x + (size_t)r * D : p.ctx + (size_t)(r - MX) * D) : p.out + (size_t)r * D;
#pragma unroll
            for (int j = 0; j < 4; ++j) v[q][j] = *(const f32x4*)(src + j * 256 + lane * 4); }
#pragma unroll
        for (int q = 0; q < 4; ++q) {
#pragma unroll
            for (int j = 0; j < 4; ++j) ss[q] += v[q][j].x * v[q][j].x + v[q][j].y * v[q][j].y + v[q][j].z * v[q][j].z + v[q][j].w * v[q][j].w;
            ss[q] = wave_sum(ss[q]); }
#pragma unroll
        for (int q = 0; q < 4; ++q) { const int r = rb + q; if (r >= r1) break;
            const int mv = row_modv(r);
            if (mv != cur) { cur = mv;
                const float* sc = mod + mv * (NMOD * D) + (which == 1 ? 1 : 4) * D;
                const float* sh = mod + mv * (NMOD * D) + (which == 1 ? 0 : 3) * D;
#pragma unroll
                for (int j = 0; j < 4; ++j) { const int c0 = j * 256 + lane * 4; fa[j] = *(const f32x4*)(w + c0) * (*(const f32x4*)(sc + c0) + 1.0f); fb[j] = *(const f32x4*)(sh + c0); } }
            const float rs = rsqrtf(ss[q] * (1.0f / D) + EPS);
#pragma unroll
            for (int j = 0; j < 4; ++j) { const int c0 = j * 256 + lane * 4;
                const f32x4 y = v[q][j] * rs * fa[j] + fb[j];
                uint2 o; o.x = pk2(y.x, y.y); o.y = pk2(y.z, y.w);
                __builtin_nontemporal_store((u32x2){o.x, o.y}, (u32x2*)(dst + (size_t)r * D + c0)); } }
    }
}

typedef float f32x2_t __attribute__((ext_vector_type(2)));
__device__ __forceinline__ f32x2_t bf2_to_f32(unsigned v) { return (f32x2_t){__uint_as_float(v << 16), __uint_as_float(v & 0xffff0000u)}; }
template <int XB>
__device__ __forceinline__ void phase_convact(const P& p, int c0, int nc, int bid, int nblk, LAS unsigned char* lds) {
    const bf16_t* U = (const bf16_t*)(p.ws + WS_U); bf16_t* ACT = (bf16_t*)(p.ws + WS_ACT);
    const int ldu = 2 * nc, ncg = nc >> 1, nthr = nblk * NTHREADS;
    LAS float* wl = (LAS float*)lds;
    for (int i = threadIdx.x; i < 9 * ldu; i += NTHREADS) { const int tap = i / ldu, cc = i - tap * ldu; wl[i] = p.ffn_conv[tap * (2 * DFF) + (cc < nc ? c0 + cc : DFF + c0 + (cc - nc))]; }
    __syncthreads();
    constexpr int NXB = 64 / XB, WC = XB + 2;
    int S = nthr / (4 * NXB * ncg); S = S < 1 ? 1 : (S > 64 ? 64 : S);
    const int LY = (128 + S - 1) / S, items = 4 * NXB * ncg * S;
    const int vbid = (nblk & 7) ? bid : (bid & 7) * (nblk >> 3) + (bid >> 3);
    const int ncw = ncg >> 6;
    for (int idx = vbid * NTHREADS + (int)threadIdx.x; idx < items; idx += nthr) {
        const int wi = __builtin_amdgcn_readfirstlane(idx >> 6);
        const int cg = (wi % ncw) * 64 + (int)(threadIdx.x & 63); int r = wi / ncw; const int xb = r % NXB; r /= NXB; const int ys = r % S, b = r / S, c = cg * 2;
        const int y0 = ys * LY, y1 = (y0 + LY < 128) ? y0 + LY : 128;
        if (y0 >= 128) continue;
        const LAS float* wq = wl + c;
        const int x0 = xb * XB;
        const bf16_t* ub = U + (size_t)(b * T) * ldu + c;
        bf16_t* ob = ACT + (size_t)(b * T) * DFF + c0 + c;
        const bool zl = xb == 0, zr = xb == NXB - 1;
        unsigned w0[WC][2], w1[WC][2], w2[WC][2], w3[WC][2];
#define CA_LOAD(W_, y_) do { const int yy_ = (y_); const bool ok_ = yy_ >= 0 && yy_ < 128; const int yc_ = yy_ < 0 ? 0 : (yy_ > 127 ? 127 : yy_); \
            _Pragma("unroll") for (int j = 0; j < WC; ++j) { const int xi_ = x0 - 1 + j, xc_ = xi_ < 0 ? 0 : (xi_ > 63 ? 63 : xi_); const bf16_t* q_ = ub + (size_t)(yc_ * 64 + xc_) * ldu; \
                const bool z_ = !ok_ || (j == 0 && zl) || (j == WC - 1 && zr); const unsigned g_ = *(const unsigned*)q_, v_ = *(const unsigned*)(q_ + nc); \
                (W_)[j][0] = z_ ? 0u : g_; (W_)[j][1] = z_ ? 0u : v_; } } while (0)
#define CA_ROW(y_, A_, B_, C_) do { f32x2_t G_[XB], V_[XB]; _Pragma("unroll") for (int j = 0; j < XB; ++j) { G_[j] = (f32x2_t){0.f, 0.f}; V_[j] = (f32x2_t){0.f, 0.f}; } \
            f32x2_t wg_[3][3], wv_[3][3]; \
            _Pragma("unroll") for (int dy = 0; dy < 3; ++dy) _Pragma("unroll") for (int dx = 0; dx < 3; ++dx) { wg_[dy][dx] = *(const LAS f32x2_t*)(wq + (dy * 3 + dx) * ldu); wv_[dy][dx] = *(const LAS f32x2_t*)(wq + (dy * 3 + dx) * ldu + nc); } \
            _Pragma("unroll") for (int col = 0; col < WC; ++col) { \
                const f32x2_t ua_ = bf2_to_f32((A_)[col][0]), ub_ = bf2_to_f32((B_)[col][0]), uc_ = bf2_to_f32((C_)[col][0]); \
                const f32x2_t va_ = bf2_to_f32((A_)[col][1]), vb_ = bf2_to_f32((B_)[col][1]), vc_ = bf2_to_f32((C_)[col][1]); \
                _Pragma("unroll") for (int dx = 0; dx < 3; ++dx) { const int j = col - dx; if (j >= 0 && j < XB) { \
                    G_[j] = G_[j] + wg_[0][dx] * ua_ + wg_[1][dx] * ub_ + wg_[2][dx] * uc_; V_[j] = V_[j] + wv_[0][dx] * va_ + wv_[1][dx] * vb_ + wv_[2][dx] * vc_; } } } \
            _Pragma("unroll") for (int j = 0; j < XB; ++j) __builtin_nontemporal_store(pk2(silu_fast(G_[j].x) * V_[j].x, silu_fast(G_[j].y) * V_[j].y), (unsigned*)(ob + (size_t)((y_) * 64 + x0 + j) * DFF)); } while (0)
        CA_LOAD(w0, y0 - 1); CA_LOAD(w1, y0); CA_LOAD(w2, y0 + 1);
#pragma unroll 1
        for (int y = y0; y < y1; y += 4) {
            CA_LOAD(w3, y + 2); CA_ROW(y, w0, w1, w2); if (y + 1 >= y1) break;
            CA_LOAD(w0, y + 3); CA_ROW(y + 1, w1, w2, w3); if (y + 2 >= y1) break;
            CA_LOAD(w1, y + 4); CA_ROW(y + 2, w2, w3, w0); if (y + 3 >= y1) break;
            CA_LOAD(w2, y + 5); CA_ROW(y + 3, w3, w0, w1);
        }
#undef CA_LOAD
#undef CA_ROW
    }
}

__device__ __forceinline__ void phase_final(const P& p, int bid, int nblk) {
    const int lane = threadIdx.x & 63, wv = threadIdx.x >> 6, nwv = blockDim.x >> 6, gwv = bid * nwv + wv, ngw = nblk * nwv;
    f32x4 fw[4];
#pragma unroll
    for (int j = 0; j < 4; ++j) fw[j] = *(const f32x4*)(p.norm_out_w + j * 256 + lane * 4);
    for (int rb = 4 * gwv; rb < MX; rb += 4 * ngw) {
        f32x4 v[4][4]; float ss[4] = {0.f, 0.f, 0.f, 0.f};
#pragma unroll
        for (int q = 0; q < 4; ++q)
#pragma unroll
            for (int j = 0; j < 4; ++j) v[q][j] = *(const f32x4*)(p.out + (size_t)(rb + q) * D + j * 256 + lane * 4);
#pragma unroll
        for (int q = 0; q < 4; ++q) {
#pragma unroll
            for (int j = 0; j < 4; ++j) ss[q] += v[q][j].x * v[q][j].x + v[q][j].y * v[q][j].y + v[q][j].z * v[q][j].z + v[q][j].w * v[q][j].w;
            ss[q] = wave_sum(ss[q]); }
#pragma unroll
        for (int q = 0; q < 4; ++q) { const float rs = rsqrtf(ss[q] * (1.0f / D) + EPS);
#pragma unroll
            for (int j = 0; j < 4; ++j) __builtin_nontemporal_store(v[q][j] * rs * fw[j], (f32x4*)(p.out + (size_t)(rb + q) * D + j * 256 + lane * 4)); }
    }
}

typedef short bf16x8 __attribute__((ext_vector_type(8)));
typedef short s16x4 __attribute__((ext_vector_type(4)));
#define MFMA16(a, b, c) __builtin_amdgcn_mfma_f32_16x16x32_bf16((a), (b), (c), 0, 0, 0)
__device__ __forceinline__ s16x4 lds_tr4(const LAS unsigned char* p) { return __builtin_bit_cast(s16x4, __builtin_amdgcn_ds_read_tr16_b64_v4i16((LAS s16x4*)p)); }
__device__ __forceinline__ bf16x8 cat8(s16x4 lo, s16x4 hi) { return (bf16x8){lo[0], lo[1], lo[2], lo[3], hi[0], hi[1], hi[2], hi[3]}; }
__device__ __forceinline__ u32x2 pack4(f32x4 v) { u32x2 o; o.x = pg8::cvt_pk_bf16(v[0], v[1]); o.y = pg8::cvt_pk_bf16(v[2], v[3]); return o; }
__device__ __forceinline__ u32x4 mk4(unsigned a, unsigned b, unsigned c, unsigned d) { return (u32x4){a, b, c, d}; }
__device__ __forceinline__ uint2 mk2h(unsigned a, unsigned b) { return make_uint2(a, b); }
__device__ __forceinline__ void lds_put64(LAS void* p, unsigned x, unsigned y) { const u32x2 v = {x, y}; asm volatile("ds_write_b64 %0, %1" :: "v"((unsigned)(size_t)p), "v"(v) : "memory"); }
#define LDS_PUT64(p_, off_, x_, y_) do { const u32x2 v2_ = {(x_), (y_)}; asm volatile("ds_write_b64 %0, %1 offset:%2" :: "v"((unsigned)(size_t)(p_)), "v"(v2_), "i"(off_) : "memory"); } while (0)
constexpr int NSTEP = 132;
__device__ __forceinline__ int chain_chunk(int b, int dir, int s) { if (s < 4) return 512 + b * 4 + (dir ? 3 - s : s); const int c = s - 4; return b * 128 + (dir ? 127 - c : c); }
__device__ __forceinline__ int chunk_row(int g, int dir, int l) { return g * 64 + (dir ? 63 - l : l); }
__device__ __forceinline__ float wave_incl_sum(float v, int lane) {
#pragma unroll
    for (int o = 1; o < 64; o <<= 1) { const float t = __shfl_up(v, o); if (lane >= o) v += t; }
    return v;
}
__device__ __forceinline__ float wave_incl_max(float v, int lane) {
#pragma unroll
    for (int o = 1; o < 64; o <<= 1) { const float t = __shfl_up(v, o); if (lane >= o) v = fmaxf(v, t); }
    return v;
}
__device__ __forceinline__ float wave_max(float v) {
#pragma unroll
    for (int o = 1; o < 64; o <<= 1) v = fmaxf(v, __shfl_xor(v, o));
    return v;
}

__device__ __forceinline__ void ml_chain_scalars(const P& p, int c, LAS float* cb) {
    const float* gates = (const float*)(p.ws + WS_GATES); float* MLS = (float*)(p.ws + WS_MLS);
    const int tid = threadIdx.x, lane = tid & 63, wid = tid >> 6;
    const int dir = c & 1, bh = c >> 1, b = bh >> 2, h = bh & 3;
    const float ib = p.ml_igate_b[dir * 4 + h], fb = p.ml_fgate_b[dir * 4 + h];
    LAS float* bl_a = cb; LAS float* tm_a = cb + 136; LAS float* m_a = cb + 272;
    constexpr int NI = (NSTEP + NWAVES - 1) / NWAVES;
    float igr[NI], fgr[NI];
#pragma unroll
    for (int i = 0; i < NI; ++i) { const int s = wid + NWAVES * i, sc = s < NSTEP ? s : NSTEP - 1; const int g = chain_chunk(b, dir, sc), row = chunk_row(g, dir, lane);
        igr[i] = gates[(size_t)row * 64 + 32 + dir * 4 + h]; fgr[i] = gates[(size_t)row * 64 + 40 + dir * 4 + h]; }
#pragma unroll
    for (int i = 0; i < NI; ++i) { const int s = wid + NWAVES * i;
        const float ig = softcapf_(igr[i] + ib);
        const float lf = -softplusf_(-softcapf_(fgr[i] + fb));
        igr[i] = ig; fgr[i] = lf;
        const float bc = wave_incl_sum(lf, lane), blast = __shfl(bc, 63);
        const float tmax = wave_max(blast + (ig - bc));
        if (lane == 0 && s < NSTEP) { bl_a[s] = blast; tm_a[s] = tmax; }
    }
    __syncthreads();
    if (tid == 0) { float m = 0.f; for (int s = 0; s < NSTEP; ++s) { m_a[s] = m; m = fmaxf(bl_a[s] + m, tm_a[s]); } }
    __syncthreads();
#pragma unroll
    for (int i = 0; i < NI; ++i) { const int s = wid + NWAVES * i;
        const float ig = igr[i], lf = fgr[i];
        const float bc = wave_incl_sum(lf, lane), blast = __shfl(bc, 63);
        const float cs = ig - bc, tail = blast + cs;
        if (s < NSTEP) {
        const float m = m_a[s], mnew = fmaxf(blast + m, tm_a[s]);
        const float wt = __expf(tail - mnew), dec = __expf(blast + m - mnew);
        const float pm = wave_incl_max(cs, lane);
        const float mt = fmaxf(bc + m, bc + pm);
        float* o = MLS + ((size_t)c * NSTEP + s) * 384;
        o[lane] = bc - mt; o[64 + lane] = cs; o[128 + lane] = __expf(bc + m - mt); o[192 + lane] = __expf(-mt); o[256 + lane] = wt; o[320 + lane] = dec; }
    }
    __syncthreads();
}

constexpr int PR_CW = 0, PR_QN = 4608, PR_KN = 22016, PR_KK = 39424, PR_QK = 56064, PR_GS = 72704, PR_A = 73728, PR_BT = 139264, PR_END = 141312;
__device__ __forceinline__ void bf8_to_f32(const u32x4 v, float (&o)[8]) {
    o[0] = __uint_as_float(v.x << 16); o[1] = __uint_as_float(v.x & 0xffff0000u); o[2] = __uint_as_float(v.y << 16); o[3] = __uint_as_float(v.y & 0xffff0000u);
    o[4] = __uint_as_float(v.z << 16); o[5] = __uint_as_float(v.z & 0xffff0000u); o[6] = __uint_as_float(v.w << 16); o[7] = __uint_as_float(v.w & 0xffff0000u);
}
__device__ __forceinline__ void phase_prep2(const P& p, int bid, int nblk, LAS unsigned char* lds) {
    bf16_t* qkv = (bf16_t*)(p.ws + WS_QKV); const bf16_t* halo = (const bf16_t*)(p.ws + WS_HALO); const float* gates = (const float*)(p.ws + WS_GATES);
    bf16_t* TB = (bf16_t*)(p.ws + WS_TB); bf16_t* ATT = (bf16_t*)(p.ws + WS_ATTN); float* GSC = (float*)(p.ws + WS_GSC);
    LAS float* cw = (LAS float*)(lds + PR_CW);
    LAS bf16_t* qn = (LAS bf16_t*)(lds + PR_QN); LAS bf16_t* kn = (LAS bf16_t*)(lds + PR_KN);
    LAS float* kk = (LAS float*)(lds + PR_KK); LAS float* qk = (LAS float*)(lds + PR_QK); LAS float* gs = (LAS float*)(lds + PR_GS);
    LAS bf16_t* Am0 = (LAS bf16_t*)(lds + PR_A);
    const int tid = threadIdx.x, lane = tid & 63, wid = tid >> 6, fr = lane & 15, fq = lane >> 4;
    if (nblk >= 32) { if (bid >= nblk - 32) ml_chain_scalars(p, bid - (nblk - 32), (LAS float*)(lds + PR_END)); }
    else { for (int c = bid; c < 32; c += nblk) ml_chain_scalars(p, c, (LAS float*)(lds + PR_END)); }
    const int NCH = MT / 64;
    int hcur = -1;
    const int r = tid >> 3, c16 = (tid & 7) * 16;
    u32x4 xr[3][3][2];
#define PREP_LOAD(item_) do { const int g_ = (item_) >> 3, h_ = (item_) & 7; bool first_, last_; \
        if (g_ < MX / 64) { first_ = (g_ & 127) == 0; last_ = (g_ & 127) == 127; } else { first_ = ((g_ - MX / 64) & 3) == 0; last_ = ((g_ - MX / 64) & 3) == 3; } \
        _Pragma("unroll") for (int pt_ = 0; pt_ < 3; ++pt_) { const int col_ = pt_ * 1024 + h_ * 128 + c16; const bf16_t* rowp_ = qkv + ((size_t)(pt_ * 8 + h_) * MT + g_ * 64 + r) * 128 + c16; \
            { const bf16_t* pp_ = r > 0 ? rowp_ - 128 : halo + ((size_t)(g_ - 1) * 2 + 1) * 3072 + col_; const bool z_ = (r == 0) && first_; \
              xr[pt_][0][0] = z_ ? (u32x4){0u, 0u, 0u, 0u} : *(const u32x4*)pp_; xr[pt_][0][1] = z_ ? (u32x4){0u, 0u, 0u, 0u} : *(const u32x4*)(pp_ + 8); } \
            xr[pt_][1][0] = *(const u32x4*)rowp_; xr[pt_][1][1] = *(const u32x4*)(rowp_ + 8); \
            { const bf16_t* pn_ = r < 63 ? rowp_ + 128 : halo + ((size_t)(g_ + 1) * 2 + 0) * 3072 + col_; const bool z_ = (r == 63) && last_; \
              xr[pt_][2][0] = z_ ? (u32x4){0u, 0u, 0u, 0u} : *(const u32x4*)pn_; xr[pt_][2][1] = z_ ? (u32x4){0u, 0u, 0u, 0u} : *(const u32x4*)(pn_ + 8); } } } while (0)
    const bool bal = (nblk == 256);
    const int reg_cnt = bal ? (bid >= 224 ? 12 : (bid < 128 ? 17 : 16)) : (bid < NCH * 8 ? (NCH * 8 - bid + nblk - 1) / nblk : 0);
    const int cnt = reg_cnt + ((bal && (bid < 32 || (bid >= 128 && bid < 224))) ? 1 : 0);
    const int xa = bid >= 128 ? (bid - 128) >> 3 : 12 + (bid >> 3);
    const int xitem = 224 + (bid & 7) + 8 * (xa >> 2) + 256 * (12 + (xa & 3));
#define PREP_ITEM(q_) ((q_) < reg_cnt ? bid + (q_) * nblk : xitem)
    for (int q0 = 0; q0 < cnt; q0 += 4) {
      int myitem = -1;
#pragma unroll 1
      for (int kb = 0; kb < 4; ++kb) {
        const int q = q0 + kb; if (q >= cnt) break;
        const int item = PREP_ITEM(q);
        const int g = item >> 3, h = item & 7;
        PREP_LOAD(item);
        float ga_pre = 0.f, gb_pre = 0.f, alog_pre = 0.f, dtb_pre = 0.f;
        if (wid < 2) { const int row_ = chunk_row(g, wid, lane); ga_pre = gates[(size_t)row_ * 64 + wid * 8 + h]; gb_pre = gates[(size_t)row_ * 64 + 16 + wid * 8 + h]; alog_pre = p.gdn_a_log[wid * 8 + h]; dtb_pre = p.gdn_dt_bias[wid * 8 + h]; }
        if (h != hcur) { __syncthreads(); for (int i = tid; i < 9 * 128; i += NTHREADS) { const int pt = i / 384, tap = (i / 128) % 3, cc = i & 127; cw[i] = p.gdn_conv[tap * 3072 + pt * 1024 + h * 128 + cc]; } hcur = h; }
        asm volatile("s_waitcnt vmcnt(0)" ::: "memory");
        __syncthreads();
#pragma unroll
        for (int part = 0; part < 3; ++part) {
            const int col = part * 1024 + h * 128 + c16;
            bf16_t* rowp = qkv + ((size_t)(part * 8 + h) * MT + g * 64 + r) * 128 + c16;
            float y[16]; float ss = 0.f;
#pragma unroll
            for (int hf = 0; hf < 2; ++hf) { float a0[8], a1[8], a2[8]; bf8_to_f32(xr[part][0][hf], a0); bf8_to_f32(xr[part][1][hf], a1); bf8_to_f32(xr[part][2][hf], a2);
#pragma unroll
                for (int i = 0; i < 8; ++i) { const int cc = c16 + hf * 8 + i; const LAS float* w = cw + part * 384 + cc;
                    const float v = silu_fast(w[0] * a0[i] + w[128] * a1[i] + w[256] * a2[i]); y[hf * 8 + i] = v; ss += v * v; } }
            float rs = 1.0f;
            if (part < 2) { ss += __shfl_xor(ss, 1); ss += __shfl_xor(ss, 2); ss += __shfl_xor(ss, 4); rs = rsqrtf(ss + EPS) * (part == 0 ? QSCALE : 1.0f); }
            u32x4 o0, o1;
            o0.x = pk2(y[0] * rs, y[1] * rs); o0.y = pk2(y[2] * rs, y[3] * rs); o0.z = pk2(y[4] * rs, y[5] * rs); o0.w = pk2(y[6] * rs, y[7] * rs);
            o1.x = pk2(y[8] * rs, y[9] * rs); o1.y = pk2(y[10] * rs, y[11] * rs); o1.z = pk2(y[12] * rs, y[13] * rs); o1.w = pk2(y[14] * rs, y[15] * rs);
            *(u32x4*)rowp = o0; *(u32x4*)(rowp + 8) = o1;
            if (part == 0) { *(LAS u32x4*)(qn + r * 136 + c16) = o0; *(LAS u32x4*)(qn + r * 136 + c16 + 8) = o1; }
            if (part == 1) { *(LAS u32x4*)(kn + r * 136 + c16) = o0; *(LAS u32x4*)(kn + r * 136 + c16 + 8) = o1; }
        }
        { const int ni = PREP_ITEM(q + 1);
          if (kb < 3 && q + 1 < cnt && tid < 384) { const int g2 = ni >> 3, h2 = ni & 7, pt2 = tid >> 7, rr2 = (tid & 127) >> 1, hf2 = tid & 1;
              const unsigned off2 = (unsigned)(((pt2 * 8 + h2) * MT + g2 * 64 + rr2) * 128 + hf2 * 64); const bf16_t* gp = qkv + off2;
              __builtin_amdgcn_global_load_lds((const unsigned*)gp, (LAS unsigned*)(lds + 152064 + wid * 256), 4, 0, 0); } }
        if (wid < 2) { const int dir = wid;
            const float alog = -__expf(alog_pre); const float xg = ga_pre + dtb_pre;
            const float gl = alog * (xg > 20.f ? xg : __logf(1.0f + __expf(xg)));
            const float gc = wave_incl_sum(gl, lane), glast = __shfl(gc, 63);
            gs[dir * 64 + lane] = gc; gs[128 + dir * 64 + lane] = sigmoidf_(gb_pre);
            float* o = GSC + ((size_t)item * 2 + dir) * 128; o[lane] = __expf(gc); o[64 + lane] = __expf(glast - gc); }
        __syncthreads();
#pragma unroll
        for (int i = 0; i < 2; ++i) { const int t = wid * 2 + i, mt = t >> 2, nt = t & 3; f32x4 a1 = {0.f, 0.f, 0.f, 0.f}, a2 = {0.f, 0.f, 0.f, 0.f};
#pragma unroll
            for (int q4 = 0; q4 < 4; ++q4) { const bf16x8 bk = *(const LAS bf16x8*)(kn + (16 * nt + fr) * 136 + 32 * q4 + 8 * fq);
                const bf16x8 ak = *(const LAS bf16x8*)(kn + (16 * mt + fr) * 136 + 32 * q4 + 8 * fq), aq = *(const LAS bf16x8*)(qn + (16 * mt + fr) * 136 + 32 * q4 + 8 * fq);
                a1 = MFMA16(ak, bk, a1); a2 = MFMA16(aq, bk, a2); }
#pragma unroll
            for (int q4 = 0; q4 < 4; ++q4) { kk[(16 * mt + 4 * fq + q4) * 65 + 16 * nt + fr] = a1[q4]; qk[(16 * mt + 4 * fq + q4) * 65 + 16 * nt + fr] = a2[q4]; } }
        __syncthreads();
        { const int dir = tid >> 8, l = (tid >> 2) & 63, s0 = (tid & 3) * 16; const int lt = dir ? 63 - l : l;
            const float gl = gs[dir * 64 + l], bl = gs[128 + dir * 64 + l]; float av[16], aa[16];
#pragma unroll
            for (int i = 0; i < 16; ++i) { const int s = s0 + i, st = dir ? 63 - s : s;
                const float dc = s <= l ? __expf(gl - gs[dir * 64 + s]) : 0.f;
                aa[i] = s < l ? bl * kk[lt * 65 + st] * dc : 0.f; av[i] = qk[lt * 65 + st] * dc; }
            { u32x4 a0_, a1_; a0_.x = pk2(aa[0], aa[1]); a0_.y = pk2(aa[2], aa[3]); a0_.z = pk2(aa[4], aa[5]); a0_.w = pk2(aa[6], aa[7]); a1_.x = pk2(aa[8], aa[9]); a1_.y = pk2(aa[10], aa[11]); a1_.z = pk2(aa[12], aa[13]); a1_.w = pk2(aa[14], aa[15]);
              LAS bf16_t* ad_ = Am0 + (kb * 2 + dir) * 4096 + l * 64 + s0; *(LAS u32x4*)ad_ = a0_; *(LAS u32x4*)(ad_ + 8) = a1_; }
            u32x4 o0, o1;
            o0.x = pk2(av[0], av[1]); o0.y = pk2(av[2], av[3]); o0.z = pk2(av[4], av[5]); o0.w = pk2(av[6], av[7]);
            o1.x = pk2(av[8], av[9]); o1.y = pk2(av[10], av[11]); o1.z = pk2(av[12], av[13]); o1.w = pk2(av[14], av[15]);
            bf16_t* ap = ATT + ((size_t)item * 2 + dir) * 4096 + l * 64 + s0; *(u32x4*)ap = o0; *(u32x4*)(ap + 8) = o1; }
        __syncthreads();
        if (wid < 2) ((LAS float*)(lds + PR_BT))[(kb * 2 + wid) * 64 + lane] = gs[128 + wid * 64 + lane];
        if ((wid >> 1) == kb) myitem = item;
      }
      __syncthreads();
      if (myitem >= 0) {
          int tl_ = tid; asm volatile("" : "+v"(tl_));
          const int lane = tl_ & 63, wid = tl_ >> 6, fr = lane & 15, fq = lane >> 4;
          const int dir = wid & 1; LAS bf16_t* A = Am0 + ((wid >> 1) * 2 + dir) * 4096;
          LAS bf16_t* Tt = (LAS bf16_t*)(lds + PR_QN) + wid * 2048; LAS bf16_t* Tr = Tt + 1024;
          const LAS float* btp = (const LAS float*)(lds + PR_BT) + ((wid >> 1) * 2 + dir) * 64;
          const int lb = lane >> 4, lr = lane & 15;
          float t[16];
#pragma unroll
          for (int rr = 0; rr < 16; ++rr) { const LAS bf16_t* ar = A + (16 * lb + rr) * 64 + 16 * lb; float av[16];
              { float h0[8], h1[8]; bf8_to_f32(*(const LAS u32x4*)ar, h0); bf8_to_f32(*(const LAS u32x4*)(ar + 8), h1);
#pragma unroll
                for (int i = 0; i < 8; ++i) { av[i] = h0[i]; av[8 + i] = h1[i]; } }
              float a0 = (rr == lr) ? 1.f : 0.f, a1 = 0.f;
#pragma unroll
              for (int sx = 0; sx < rr; ++sx) { if (sx & 1) a1 -= av[sx] * t[sx]; else a0 -= av[sx] * t[sx]; }
              t[rr] = a0 + a1; }
          { u32x4 p0, p1; p0.x = pk2(t[0], t[1]); p0.y = pk2(t[2], t[3]); p0.z = pk2(t[4], t[5]); p0.w = pk2(t[6], t[7]); p1.x = pk2(t[8], t[9]); p1.y = pk2(t[10], t[11]); p1.z = pk2(t[12], t[13]); p1.w = pk2(t[14], t[15]);
            *(LAS u32x4*)(Tt + (16 * lb + lr) * 16) = p0; *(LAS u32x4*)(Tt + (16 * lb + lr) * 16 + 8) = p1;
#pragma unroll
            for (int rr = 0; rr < 16; ++rr) Tr[(16 * lb + rr) * 16 + lr] = f2bf(t[rr]); }
          asm volatile("s_waitcnt lgkmcnt(0)" ::: "memory");
#define INV_W8(v_) ((bf16x8){(v_)[0], (v_)[1], (v_)[2], (v_)[3], 0, 0, 0, 0})
#define INV_MF(a_, b_, c_) MFMA16(INV_W8(a_), INV_W8(b_), (c_))
#define INV_AOP(i_, k_) (*(const LAS s16x4*)(A + (16 * (i_) + fr) * 64 + 16 * (k_) + 4 * fq))
#define INV_DCOL(j_) (*(const LAS s16x4*)(Tt + (16 * (j_) + fr) * 16 + 4 * fq))
#define INV_DROW(i_) (*(const LAS s16x4*)(Tr + (16 * (i_) + fr) * 16 + 4 * fq))
#define INV_PK(v_) __builtin_bit_cast(s16x4, pack4(v_))
#define INV_FIN(dst_, drow_, s_) do { const f32x4 ns_ = -(s_); const u32x2 hi_ = pack4(ns_); const f32x4 lo_ = ns_ - bf4_to_f32(make_uint2(hi_.x, hi_.y)); \
              (dst_) = INV_MF((drow_), __builtin_bit_cast(s16x4, hi_), z4); (dst_) = INV_MF((drow_), INV_PK(lo_), (dst_)); } while (0)
          { const f32x4 z4 = {0.f, 0.f, 0.f, 0.f};
            const s16x4 a10 = INV_AOP(1, 0), a21 = INV_AOP(2, 1), a32 = INV_AOP(3, 2), a20 = INV_AOP(2, 0), a31 = INV_AOP(3, 1), a30 = INV_AOP(3, 0);
            const s16x4 c0 = INV_DCOL(0), c1 = INV_DCOL(1), c2 = INV_DCOL(2), r1 = INV_DROW(1), r2 = INV_DROW(2), r3 = INV_DROW(3);
            f32x4 T10, T21, T32, T20, T31, T30, S;
            S = INV_MF(a10, c0, z4); INV_FIN(T10, r1, S);
            S = INV_MF(a21, c1, z4); INV_FIN(T21, r2, S);
            S = INV_MF(a32, c2, z4); INV_FIN(T32, r3, S);
            const s16x4 b10 = INV_PK(T10), b21 = INV_PK(T21);
            S = INV_MF(a20, c0, z4); S = INV_MF(a21, b10, S); INV_FIN(T20, r2, S);
            S = INV_MF(a31, c1, z4); S = INV_MF(a32, b21, S); INV_FIN(T31, r3, S);
            const s16x4 b20 = INV_PK(T20);
            S = INV_MF(a30, c0, z4); S = INV_MF(a31, b10, S); S = INV_MF(a32, b20, S); INV_FIN(T30, r3, S);
            asm volatile("" ::: "memory");
#define INV_PUT(T_, i_, j_) do { const float bt_ = btp[16 * (j_) + fr]; _Pragma("unroll") for (int q4 = 0; q4 < 4; ++q4) A[(16 * (i_) + 4 * fq + q4) * 64 + 16 * (j_) + fr] = f2bf((T_)[q4] * bt_); } while (0)
            INV_PUT(T10, 1, 0); INV_PUT(T21, 2, 1); INV_PUT(T32, 3, 2); INV_PUT(T20, 2, 0); INV_PUT(T31, 3, 1); INV_PUT(T30, 3, 0);
            { const float bt_ = btp[16 * lb + lr];
#pragma unroll
              for (int rr = 0; rr < 16; ++rr) A[(16 * lb + rr) * 64 + 16 * lb + lr] = f2bf(t[rr] * bt_); }
            asm volatile("s_waitcnt lgkmcnt(0)" ::: "memory"); }
#undef INV_MF
#undef INV_W8
#undef INV_AOP
#undef INV_DCOL
#undef INV_DROW
#undef INV_PK
#undef INV_FIN
#undef INV_PUT
          bf16_t* o = TB + ((size_t)myitem * 2 + dir) * 4096;
#pragma unroll
          for (int i8 = 0; i8 < 8; ++i8) { const int row = (lane >> 3) + 8 * i8, c8 = (lane & 7) * 8; *(u32x4*)(o + row * 64 + c8) = *(const LAS u32x4*)(A + row * 64 + c8); } }
      __syncthreads();
    }
#undef PREP_LOAD
#undef PREP_ITEM
}

constexpr int SC_TEAM = 81856;
constexpr int G2_K0 = 0, G2_K1 = 17408, G2_QC = 34816, G2_TB = 52224, G2_AT = 61440, G2_VC = 70656, G2_SC = 79872, G2_END = 80896;
static_assert(G2_END <= SC_TEAM, "gdn2 lds");
constexpr int XSTEP = 68;
__device__ __forceinline__ bf16x8 pack8f(const f32x4 a, const f32x4 b) { const u32x2 x = pack4(a), y = pack4(b); return __builtin_bit_cast(bf16x8, mk4(x.x, x.y, y.x, y.y)); }
__device__ __forceinline__ void gdn_scan2(const P& p, int n, LAS unsigned char* lds) {
    const bf16_t* qkv = (const bf16_t*)(p.ws + WS_QKV); const bf16_t* TB = (const bf16_t*)(p.ws + WS_TB); const bf16_t* ATT = (const bf16_t*)(p.ws + WS_ATTN);
    const float* GSC = (const float*)(p.ws + WS_GSC); bf16_t* O = (bf16_t*)p.out;
    const int tid = threadIdx.x, lane = tid & 63, wid = tid >> 6, tt = tid & 255, fr = lane & 15, fq = lane >> 4;
    const bool loader = wid >= 4;
    const int dir = loader ? 0 : (wid >> 1), tw = wid & 1;
    const int bh = n >> 2, dvq = n & 3, b = bh >> 3, h = bh & 7;
    LAS unsigned char* L = lds + dir * SC_TEAM;
    LAS bf16_t* Qc = (LAS bf16_t*)(L + G2_QC); LAS bf16_t* Tbc = (LAS bf16_t*)(L + G2_TB); LAS bf16_t* Atc = (LAS bf16_t*)(L + G2_AT); LAS bf16_t* Vc = (LAS bf16_t*)(L + G2_VC);
    const int srow = tt >> 2, sq = tt & 3;
#define G2_CLAMP(s_) ((s_) < NSTEP ? (s_) : NSTEP - 1)
#define G2_FX_K(s_) do { _Pragma("unroll") for (int d_ = 0; d_ < 2; ++d_) { const int g_ = chain_chunk(b, d_, (s_)); \
        const bf16_t* rp_ = qkv + ((size_t)h * MT + chunk_row(g_, d_, srow)) * 128 + (size_t)8 * MT * 128 + sq * 32; \
        _Pragma("unroll") for (int i_ = 0; i_ < 4; ++i_) kst[d_][i_] = *(const u32x4*)(rp_ + 8 * i_); \
        scv[d_] = GSC[((size_t)(g_ * 8 + h) * 2 + d_) * 128 + (tt & 127)]; } } while (0)
#define G2_FX_T(s_, tst, ast, ost) do { _Pragma("unroll") for (int d_ = 0; d_ < 2; ++d_) { const int g_ = chain_chunk(b, d_, (s_)); const size_t it_ = ((size_t)(g_ * 8 + h) * 2 + d_); \
        const bf16_t* tp_ = TB + it_ * 4096 + srow * 64 + sq * 16; const bf16_t* ap_ = ATT + it_ * 4096 + srow * 64 + sq * 16; \
        tst[d_][0] = *(const u32x4*)tp_; tst[d_][1] = *(const u32x4*)(tp_ + 8); ast[d_][0] = *(const u32x4*)ap_; ast[d_][1] = *(const u32x4*)(ap_ + 8); \
        const int go_ = g_ < 512 ? g_ : 511; ost[d_] = *(const u32x4*)(O + (size_t)chunk_row(go_, d_, srow) * 1024 + h * 128 + dvq * 32 + sq * 8); } } while (0)
#define G2_FY(s_) do { _Pragma("unroll") for (int d_ = 0; d_ < 2; ++d_) { const int g_ = chain_chunk(b, d_, (s_)); \
        const bf16_t* rp_ = qkv + ((size_t)h * MT + chunk_row(g_, d_, srow)) * 128; \
        _Pragma("unroll") for (int i_ = 0; i_ < 4; ++i_) qst[d_][i_] = *(const u32x4*)(rp_ + sq * 32 + 8 * i_); \
        vst[d_] = *(const u32x4*)(rp_ + (size_t)16 * MT * 128 + dvq * 32 + sq * 8); } } while (0)
#define G2_PUT(dst_, i_, v_) do { LDS_PUT64((dst_), 8 * (((i_) < 2) ? 4 * (i_) : 4 * ((i_) - 2) + 1), (v_).x, (v_).y); LDS_PUT64((dst_), 8 * ((((i_) < 2) ? 4 * (i_) : 4 * ((i_) - 2) + 1) + 2), (v_).z, (v_).w); } while (0)
#define G2_WX_K(par_) do { _Pragma("unroll") for (int d_ = 0; d_ < 2; ++d_) { LAS unsigned char* Ld_ = lds + d_ * SC_TEAM; \
        LAS bf16_t* kd_ = (LAS bf16_t*)(Ld_ + G2_K0 + (par_) * (G2_K1 - G2_K0)) + srow * 136 + sq * 32; \
        _Pragma("unroll") for (int i_ = 0; i_ < 4; ++i_) G2_PUT(kd_, i_, kst[d_][i_]); \
        ((LAS float*)(Ld_ + G2_SC + (par_) * 512))[tt & 127] = scv[d_]; } } while (0)
#define G2_WX_T(tst, ast, ost) do { _Pragma("unroll") for (int d_ = 0; d_ < 2; ++d_) { LAS unsigned char* Ld_ = lds + d_ * SC_TEAM; \
        LAS bf16_t* td_ = (LAS bf16_t*)(Ld_ + G2_TB) + srow * 72 + (sq >> 1) * 32 + (sq & 1) * 4; LAS bf16_t* ad_ = (LAS bf16_t*)(Ld_ + G2_AT) + srow * 72 + (sq >> 1) * 32 + (sq & 1) * 4; \
        G2_PUT(td_, 0, tst[d_][0]); G2_PUT(td_, 1, tst[d_][1]); G2_PUT(ad_, 0, ast[d_][0]); G2_PUT(ad_, 1, ast[d_][1]); \
        *(LAS u32x4*)((LAS bf16_t*)(Ld_ + G2_VC) + srow * 72 + 32 + sq * 8) = ost[d_]; } } while (0)
#define G2_WY() do { _Pragma("unroll") for (int d_ = 0; d_ < 2; ++d_) { LAS unsigned char* Ld_ = lds + d_ * SC_TEAM; \
        LAS bf16_t* qd_ = (LAS bf16_t*)(Ld_ + G2_QC) + srow * 136 + sq * 32; \
        _Pragma("unroll") for (int i_ = 0; i_ < 4; ++i_) G2_PUT(qd_, i_, qst[d_][i_]); \
        *(LAS u32x4*)((LAS bf16_t*)(Ld_ + G2_VC) + srow * 72 + sq * 8) = vst[d_]; } } while (0)
    if (loader) {
        u32x4 kst[2][4], qst[2][4], vst[2], tsA[2][2], asA[2][2], osA[2], tsB[2][2], asB[2][2], osB[2]; float scv[2];
        G2_FX_K(0); G2_FY(0);
        G2_WX_K(0); G2_WY();
        G2_FX_T(0, tsA, asA, osA); asm volatile("" ::: "memory"); G2_FX_T(1, tsB, asB, osB); asm volatile("" ::: "memory"); G2_FX_K(1); G2_FY(1);
        asm volatile("s_waitcnt lgkmcnt(0)" ::: "memory");
        __syncthreads();
#pragma unroll 1
        for (int s = 0; s < NSTEP; s += 2) {
            const int s2 = G2_CLAMP(s + 2), s3 = G2_CLAMP(s + 3);
            G2_WX_T(tsA, asA, osA);
            G2_FX_T(s2, tsA, asA, osA);
            asm volatile("s_waitcnt lgkmcnt(0)" ::: "memory");
            __syncthreads();
            G2_WX_K((s + 1) & 1); G2_WY();
            G2_FX_K(s2); G2_FY(s2);
            asm volatile("s_waitcnt lgkmcnt(0)" ::: "memory");
            __syncthreads();
            G2_WX_T(tsB, asB, osB);
            G2_FX_T(s3, tsB, asB, osB);
            asm volatile("s_waitcnt lgkmcnt(0)" ::: "memory");
            __syncthreads();
            G2_WX_K(s & 1); G2_WY();
            G2_FX_K(s3); G2_FY(s3);
            asm volatile("s_waitcnt lgkmcnt(0)" ::: "memory");
            __syncthreads();
        }
    } else {
    f32x4 accS[8];
#pragma unroll
    for (int i = 0; i < 8; ++i) accS[i] = (f32x4){0.f, 0.f, 0.f, 0.f};
    __syncthreads();
    const size_t ocol = (size_t)h * 128 + dvq * 32 + tw * 16 + 4 * fq;
    for (int s = 0; s < NSTEP; ++s) {
        const bool isx = s >= 4; const int g = chain_chunk(b, dir, s);
        const bool second = s >= XSTEP;
        const LAS bf16_t* Kc = (const LAS bf16_t*)(L + G2_K0 + (s & 1) * (G2_K1 - G2_K0)); const LAS float* SC = (const LAS float*)(L + G2_SC + (s & 1) * 512);
        bf16x8 Sf[4];
#pragma unroll
        for (int kk = 0; kk < 4; ++kk) Sf[kk] = pack8f(accS[2 * kk], accS[2 * kk + 1]);
        f32x4 aR[4], aQ[4];
#pragma unroll
        for (int mt = 0; mt < 4; ++mt) { aR[mt] = (f32x4){0.f, 0.f, 0.f, 0.f}; aQ[mt] = (f32x4){0.f, 0.f, 0.f, 0.f}; }
        { bf16x8 kfb[2][4], qfb[2][4];
#pragma unroll
            for (int mt = 0; mt < 4; ++mt) { kfb[0][mt] = *(const LAS bf16x8*)(Kc + (16 * mt + fr) * 136 + 8 * fq); if (isx) qfb[0][mt] = *(const LAS bf16x8*)(Qc + (16 * mt + fr) * 136 + 8 * fq); }
#pragma unroll
            for (int kk = 0; kk < 4; ++kk) {
                if (kk + 1 < 4) {
#pragma unroll
                    for (int mt = 0; mt < 4; ++mt) { kfb[(kk + 1) & 1][mt] = *(const LAS bf16x8*)(Kc + (16 * mt + fr) * 136 + 32 * (kk + 1) + 8 * fq); if (isx) qfb[(kk + 1) & 1][mt] = *(const LAS bf16x8*)(Qc + (16 * mt + fr) * 136 + 32 * (kk + 1) + 8 * fq); } }
#pragma unroll
                for (int mt = 0; mt < 4; ++mt) { aR[mt] = MFMA16(kfb[kk & 1][mt], Sf[kk], aR[mt]); if (isx) aQ[mt] = MFMA16(Sf[kk], qfb[kk & 1][mt], aQ[mt]); } } }
        bf16x8 Rf[2];
        { f32x4 r[4];
#pragma unroll
            for (int h2 = 0; h2 < 2; ++h2) { const LAS unsigned char* va = (const LAS unsigned char*)(Vc + (32 * h2 + 8 * fq + (fr >> 2)) * 72 + 16 * tw + 4 * (fr & 3));
                const bf16x8 vf = cat8(lds_tr4(va), lds_tr4(va + 4 * 72 * 2));
#pragma unroll
                for (int e = 0; e < 2; ++e) { const int mt = 2 * h2 + e; const f32x4 eg4 = *(const LAS f32x4*)(SC + 16 * mt + 4 * fq);
                    bf16x8 es;
#pragma unroll
                    for (int j = 0; j < 8; ++j) es[j] = (8 * fq + j == 16 * e + fr) ? (short)0x3F80 : (short)0;
                    const f32x4 vA = MFMA16(es, vf, ((f32x4){0.f, 0.f, 0.f, 0.f})); r[mt] = vA - eg4 * aR[mt]; } }
            Rf[0] = pack8f(r[0], r[1]); Rf[1] = pack8f(r[2], r[3]); }
        __syncthreads();
        f32x4 aV[4];
#pragma unroll
        for (int mt = 0; mt < 4; ++mt) { aV[mt] = (f32x4){0.f, 0.f, 0.f, 0.f};
#pragma unroll
            for (int kk = 0; kk < 2; ++kk) if (kk <= (mt >> 1)) { const bf16x8 tf = *(const LAS bf16x8*)(Tbc + (16 * mt + fr) * 72 + 32 * kk + 8 * fq); aV[mt] = MFMA16(tf, Rf[kk], aV[mt]); } }
        bf16x8 VNf[2], VSf[2];
        { f32x4 sv[4];
#pragma unroll
            for (int mt = 0; mt < 4; ++mt) { const f32x4 et4 = *(const LAS f32x4*)(SC + 64 + 16 * mt + 4 * fq); sv[mt] = et4 * aV[mt]; }
            VNf[0] = pack8f(aV[0], aV[1]); VNf[1] = pack8f(aV[2], aV[3]); VSf[0] = pack8f(sv[0], sv[1]); VSf[1] = pack8f(sv[2], sv[3]); }
        u32x2 oprev[4];
        if (s == XSTEP) {
#pragma unroll
            for (int mt = 0; mt < 4; ++mt) oprev[mt] = *(const u32x2*)(O + (size_t)chunk_row(g, dir, 16 * mt + fr) * 1024 + ocol);
        } else if (second) {
#pragma unroll
            for (int mt = 0; mt < 4; ++mt) oprev[mt] = *(const LAS u32x2*)(Vc + (16 * mt + fr) * 72 + 32 + 16 * tw + 4 * fq); }
        if (isx) {
#pragma unroll
            for (int mt = 0; mt < 4; ++mt) { const float egl = SC[16 * mt + fr]; f32x4 o = aQ[mt] * egl;
#pragma unroll
                for (int kk = 0; kk < 2; ++kk) if (kk <= (mt >> 1)) { const bf16x8 af = *(const LAS bf16x8*)(Atc + (16 * mt + fr) * 72 + 32 * kk + 8 * fq); o = MFMA16(VNf[kk], af, o); }
                if (second) o = o + bf4_to_f32(make_uint2(oprev[mt].x, oprev[mt].y));
                *(u32x2*)(O + (size_t)chunk_row(g, dir, 16 * mt + fr) * 1024 + ocol) = pack4(o); } }
        { const float gt = SC[63];
#pragma unroll
            for (int md = 0; md < 8; ++md) accS[md] = accS[md] * gt; }
#pragma unroll
        for (int kk = 0; kk < 2; ++kk) { bf16x8 ktf[8];
#pragma unroll
            for (int md = 0; md < 8; ++md) { const LAS unsigned char* ka = (const LAS unsigned char*)(Kc + (32 * kk + 4 * fq + (fr >> 2)) * 136 + (md >> 1) * 32 + (2 * (fr & 3) + (md & 1)) * 4);
                ktf[md] = cat8(lds_tr4(ka), lds_tr4(ka + 16 * 136 * 2)); }
#pragma unroll
            for (int md = 0; md < 8; ++md) accS[md] = MFMA16(ktf[md], VSf[kk], accS[md]); }
        __syncthreads();
    }
    }
#undef G2_CLAMP
#undef G2_FX_K
#undef G2_FX_T
#undef G2_FY
#undef G2_PUT
#undef G2_WX_K
#undef G2_WX_T
#undef G2_WY
}

constexpr int M2_K0 = 0, M2_K1 = 17408, M2_QC = 34816, M2_VV = 52224, M2_P = 61440, M2_OP = 70656, M2_SC = 75776, M2_END = 78336;
static_assert(M2_END <= SC_TEAM, "ml2 lds");
__device__ __forceinline__ void ml_scan2(const P& p, int n, LAS unsigned char* lds) {
    const bf16_t* ml = (const bf16_t*)(p.ws + WS_ML); const float* MLS = (const float*)(p.ws + WS_MLS); bf16_t* HM = (bf16_t*)p.out + (size_t)MX * 1024;
    const int tid = threadIdx.x, lane = tid & 63, wid = tid >> 6, tt = tid & 255, fr = lane & 15, fq = lane >> 4;
    const bool loader = wid >= 4;
    const int dir = loader ? 0 : (wid >> 1), tw = wid & 1;
    const int bh = n >> 3, dv8 = n & 7, b = bh >> 2, h = bh & 3, chain = bh * 2 + dir;
    LAS unsigned char* L = lds + dir * SC_TEAM;
    LAS bf16_t* Qc = (LAS bf16_t*)(L + M2_QC); LAS bf16_t* VV = (LAS bf16_t*)(L + M2_VV); LAS bf16_t* Pc = (LAS bf16_t*)(L + M2_P); LAS bf16_t* OPc = (LAS bf16_t*)(L + M2_OP);
    const int srow = tt >> 2, sq = tt & 3;
#define M2_CLAMP(s_) ((s_) < NSTEP ? (s_) : NSTEP - 1)
#define M2_FX_K(s_) do { _Pragma("unroll") for (int d_ = 0; d_ < 2; ++d_) { const int g_ = chain_chunk(b, d_, (s_)); const float* sc_ = MLS + ((size_t)(bh * 2 + d_) * NSTEP + (s_)) * 384; \
        const size_t rr_ = (size_t)h * MT + chunk_row(g_, d_, srow); \
        _Pragma("unroll") for (int i_ = 0; i_ < 4; ++i_) kst[d_][i_] = *(const u32x4*)(ml + (size_t)4 * MT * 128 + rr_ * 128 + sq * 32 + 8 * i_); \
        scv[d_] = sc_[tt]; wt2[d_] = sc_[256 + (tt & 63)]; } } while (0)
#define M2_FX_T(s_) do { _Pragma("unroll") for (int d_ = 0; d_ < 2; ++d_) { const int g_ = chain_chunk(b, d_, (s_)); const float* sc_ = MLS + ((size_t)(bh * 2 + d_) * NSTEP + (s_)) * 384; \
        const size_t rr_ = (size_t)h * MT + chunk_row(g_, d_, srow); \
        vst[d_] = *(const u32x4*)(ml + (size_t)8 * MT * 128 + rr_ * 256 + dv8 * 32 + sq * 8); wtv[d_] = sc_[256 + srow]; \
        const int go_ = g_ < 512 ? g_ : 511; ost[d_] = *(const u32x4*)(HM + (size_t)chunk_row(go_, d_, srow) * 1024 + h * 256 + dv8 * 32 + sq * 8); } } while (0)
#define M2_FY(s_) do { _Pragma("unroll") for (int d_ = 0; d_ < 2; ++d_) { const int g_ = chain_chunk(b, d_, (s_)); \
        const size_t rr_ = (size_t)h * MT + chunk_row(g_, d_, srow); \
        _Pragma("unroll") for (int i_ = 0; i_ < 4; ++i_) qst[d_][i_] = *(const u32x4*)(ml + rr_ * 128 + sq * 32 + 8 * i_); } } while (0)
#define M2_PUT(dst_, i_, v_) do { LDS_PUT64((dst_), 8 * (((i_) < 2) ? 4 * (i_) : 4 * ((i_) - 2) + 1), (v_).x, (v_).y); LDS_PUT64((dst_), 8 * ((((i_) < 2) ? 4 * (i_) : 4 * ((i_) - 2) + 1) + 2), (v_).z, (v_).w); } while (0)
#define M2_WX_K(par_) do { _Pragma("unroll") for (int d_ = 0; d_ < 2; ++d_) { LAS unsigned char* Ld_ = lds + d_ * SC_TEAM; \
        LAS bf16_t* kd_ = (LAS bf16_t*)(Ld_ + M2_K0 + (par_) * (M2_K1 - M2_K0)) + srow * 136 + sq * 32; \
        _Pragma("unroll") for (int i_ = 0; i_ < 4; ++i_) M2_PUT(kd_, i_, kst[d_][i_]); \
        LAS float* Sd_ = (LAS float*)(Ld_ + M2_SC + (par_) * 1280); Sd_[tt] = scv[d_]; Sd_[256 + (tt & 63)] = wt2[d_]; } } while (0)
#define M2_WX_T() do { _Pragma("unroll") for (int d_ = 0; d_ < 2; ++d_) { LAS unsigned char* Ld_ = lds + d_ * SC_TEAM; LAS bf16_t* Vd_ = (LAS bf16_t*)(Ld_ + M2_VV) + srow * 72 + sq * 8; \
        *(LAS u32x4*)Vd_ = vst[d_]; \
        { const f32x4 a_ = bf4_to_f32(make_uint2(vst[d_].x, vst[d_].y)) * wtv[d_], b_ = bf4_to_f32(make_uint2(vst[d_].z, vst[d_].w)) * wtv[d_]; const u32x2 pa_ = pack4(a_), pb_ = pack4(b_); \
          *(LAS u32x4*)(Vd_ + 32) = mk4(pa_.x, pa_.y, pb_.x, pb_.y); } \
        *(LAS u32x4*)((LAS bf16_t*)(Ld_ + M2_OP) + srow * 40 + sq * 8) = ost[d_]; } } while (0)
#define M2_WY() do { _Pragma("unroll") for (int d_ = 0; d_ < 2; ++d_) { LAS unsigned char* Ld_ = lds + d_ * SC_TEAM; \
        LAS bf16_t* qd_ = (LAS bf16_t*)(Ld_ + M2_QC) + srow * 136 + sq * 32; \
        _Pragma("unroll") for (int i_ = 0; i_ < 4; ++i_) M2_PUT(qd_, i_, qst[d_][i_]); } } while (0)
    if (loader) {
        u32x4 kst[2][4], qst[2][4], vst[2], ost[2]; float scv[2], wtv[2], wt2[2];
        M2_FX_K(0); M2_FY(0);
        M2_WX_K(0); M2_WY();
        M2_FX_T(0); M2_FX_K(1); asm volatile("" ::: "memory"); M2_FY(1);
        asm volatile("s_waitcnt lgkmcnt(0)" ::: "memory");
        __syncthreads();
#pragma unroll 1
        for (int s = 0; s < NSTEP; ++s) {
            const int s1 = M2_CLAMP(s + 1), s2 = M2_CLAMP(s + 2);
            M2_WX_T();
            M2_FX_T(s1);
            asm volatile("s_waitcnt lgkmcnt(0)" ::: "memory");
            __syncthreads();
            M2_WX_K((s + 1) & 1); M2_WY();
            M2_FX_K(s2); M2_FY(s2);
            asm volatile("s_waitcnt lgkmcnt(0)" ::: "memory");
            __syncthreads();
        }
    } else {
    f32x4 accC[8], accN[8];
#pragma unroll
    for (int i = 0; i < 8; ++i) { accC[i] = (f32x4){0.f, 0.f, 0.f, 0.f}; accN[i] = (f32x4){0.f, 0.f, 0.f, 0.f}; }
    float dec = MLS[((size_t)chain * NSTEP + 0) * 384 + 320], n_dec = 0.f;
    __syncthreads();
    const size_t ocol = (size_t)h * 256 + dv8 * 32 + tw * 16 + 4 * fq;
    const short one_or_zero = (fr == 0) ? (short)0x3F80 : (short)0;
    for (int s = 0; s < NSTEP; ++s) {
        const bool isx = s >= 4, more = s + 1 < NSTEP; const int g = chain_chunk(b, dir, s);
        const bool second = s >= XSTEP;
        const LAS bf16_t* Kc = (const LAS bf16_t*)(L + M2_K0 + (s & 1) * (M2_K1 - M2_K0)); const LAS float* SC = (const LAS float*)(L + M2_SC + (s & 1) * 1280);
        if (more) n_dec = MLS[((size_t)chain * NSTEP + (s + 1)) * 384 + 320];
        f32x4 num[4], den[4];
        if (isx) {
#define M2_PFIN(a_, rt_, st_) do { const int l_ = 16 * (rt_) + fr; const float bl_ = SC[l_]; const f32x4 cs4_ = *(const LAS f32x4*)(SC + 64 + 16 * (st_) + 4 * fq); \
            _Pragma("unroll") for (int q4 = 0; q4 < 4; ++q4) { const int sx_ = 16 * (st_) + 4 * fq + q4; (a_)[q4] = sx_ <= l_ ? (a_)[q4] * __expf(bl_ + cs4_[q4]) : 0.f; } \
            *(LAS u32x2*)(Pc + l_ * 72 + 16 * (st_) + 4 * fq) = pack4(a_); } while (0)
#define M2_LDF(dst_, base_, row_) do { _Pragma("unroll") for (int kk = 0; kk < 4; ++kk) (dst_)[kk] = *(const LAS bf16x8*)((base_) + (16 * (row_) + fr) * 136 + 32 * kk + 8 * fq); } while (0)
#define M2_MM(acc_, kf_, qf_) do { _Pragma("unroll") for (int kk = 0; kk < 4; ++kk) (acc_) = MFMA16((kf_)[kk], (qf_)[kk], (acc_)); } while (0)
            bf16x8 Cf[4], Nf[4];
#pragma unroll
            for (int kk = 0; kk < 4; ++kk) { Cf[kk] = pack8f(accC[2 * kk], accC[2 * kk + 1]); Nf[kk] = pack8f(accN[2 * kk], accN[2 * kk + 1]); }
#pragma unroll
            for (int mt = 3; mt >= 0; --mt) { bf16x8 qf[4]; M2_LDF(qf, Qc, mt);
                num[mt] = (f32x4){0.f, 0.f, 0.f, 0.f}; den[mt] = (f32x4){0.f, 0.f, 0.f, 0.f};
#pragma unroll
                for (int kk = 0; kk < 4; ++kk) { num[mt] = MFMA16(Cf[kk], qf[kk], num[mt]); den[mt] = MFMA16(Nf[kk], qf[kk], den[mt]); }
                if (tw == ((mt == 1 || mt == 2) ? 1 : 0)) {
#pragma unroll
                    for (int st = 0; st <= mt; ++st) { bf16x8 kA[4]; f32x4 a0 = {0.f, 0.f, 0.f, 0.f}; M2_LDF(kA, Kc, st); M2_MM(a0, kA, qf); M2_PFIN(a0, mt, st); }
                    if (mt == 0) *(LAS u32x2*)(Pc + fr * 72 + 16 + 4 * fq) = (u32x2){0u, 0u};
                    if (mt == 2) *(LAS u32x2*)(Pc + (32 + fr) * 72 + 48 + 4 * fq) = (u32x2){0u, 0u};
                }
                const float it = SC[128 + 16 * mt + fr];
                num[mt] = num[mt] * it; den[mt] = den[mt] * it; }
#undef M2_PFIN
#undef M2_LDF
#undef M2_MM
        }
        __syncthreads();
        if (isx) {
            u32x2 oprev[4];
            if (s == XSTEP) {
#pragma unroll
                for (int mt = 0; mt < 4; ++mt) oprev[mt] = *(const u32x2*)(HM + (size_t)chunk_row(g, dir, 16 * mt + fr) * 1024 + ocol);
            } else if (second) {
#pragma unroll
                for (int mt = 0; mt < 4; ++mt) oprev[mt] = *(const LAS u32x2*)(OPc + (16 * mt + fr) * 40 + 16 * tw + 4 * fq); }
            bf16x8 vAf[2], onesA;
#pragma unroll
            for (int j = 0; j < 8; ++j) onesA[j] = one_or_zero;
#pragma unroll
            for (int kk = 0; kk < 2; ++kk) { const LAS unsigned char* va = (const LAS unsigned char*)(VV + (32 * kk + 8 * fq + (fr >> 2)) * 72 + 16 * tw + 4 * (fr & 3)); vAf[kk] = cat8(lds_tr4(va), lds_tr4(va + 4 * 72 * 2)); }
#pragma unroll
            for (int mt = 0; mt < 4; ++mt) {
                f32x4 nm = num[mt], dn4 = den[mt];
#pragma unroll
                for (int kk = 0; kk < 2; ++kk) if (kk <= (mt >> 1)) { const bf16x8 pf = *(const LAS bf16x8*)(Pc + (16 * mt + fr) * 72 + 32 * kk + 8 * fq); nm = MFMA16(vAf[kk], pf, nm); dn4 = MFMA16(onesA, pf, dn4); }
                const float dsum = __shfl(dn4[0], fr);
                const float dn = fmaxf(fabsf(dsum), SC[192 + 16 * mt + fr]);
                f32x4 o = nm * __builtin_amdgcn_rcpf(dn);
                if (second) o = o + bf4_to_f32(make_uint2(oprev[mt].x, oprev[mt].y));
                *(u32x2*)(HM + (size_t)chunk_row(g, dir, 16 * mt + fr) * 1024 + ocol) = pack4(o);
            }
        }
        {
#pragma unroll
            for (int md = 0; md < 8; ++md) { accC[md] = accC[md] * dec; accN[md] = accN[md] * dec; }
#pragma unroll
            for (int kk = 0; kk < 2; ++kk) { const LAS unsigned char* wa = (const LAS unsigned char*)(VV + (32 * kk + 8 * fq + (fr >> 2)) * 72 + 32 + 16 * tw + 4 * (fr & 3));
                const bf16x8 vwf = cat8(lds_tr4(wa), lds_tr4(wa + 4 * 72 * 2));
                const f32x4 w0 = *(const LAS f32x4*)(SC + 256 + 32 * kk + 8 * fq), w1 = *(const LAS f32x4*)(SC + 256 + 32 * kk + 8 * fq + 4);
                bf16x8 wtf = pack8f(w0, w1); if (fr != 0) wtf = (bf16x8){0, 0, 0, 0, 0, 0, 0, 0};
                bf16x8 ktf[8];
#pragma unroll
                for (int md = 0; md < 8; ++md) { const LAS unsigned char* ka = (const LAS unsigned char*)(Kc + (32 * kk + 8 * fq + (fr >> 2)) * 136 + (md >> 1) * 32 + (2 * (fr & 3) + (md & 1)) * 4);
                    ktf[md] = cat8(lds_tr4(ka), lds_tr4(ka + 4 * 136 * 2)); }
#pragma unroll
                for (int md = 0; md < 8; ++md) { accC[md] = MFMA16(ktf[md], vwf, accC[md]); accN[md] = MFMA16(ktf[md], wtf, accN[md]); } }
        }
        __syncthreads();
        dec = n_dec;
    }
    }
#undef M2_CLAMP
#undef M2_FX_K
#undef M2_FX_T
#undef M2_FY
#undef M2_PUT
#undef M2_WX_K
#undef M2_WX_T
#undef M2_WY
}

__device__ __forceinline__ void late_weights(const P& p, int gw, int ngw, LAS unsigned char* lds) {
    bf16_t* WINO = (bf16_t*)(p.ws + WS_WINO); bf16_t* WBG = (bf16_t*)(p.ws + WS_WBG); bf16_t* WBM = (bf16_t*)(p.ws + WS_WBM); bf16_t* WOUT = (bf16_t*)(p.ws + WS_WOUT);
    bf16_t* WUP = (bf16_t*)(p.ws + WS_WUP); bf16_t* WDOWN = (bf16_t*)(p.ws + WS_WDOWN);
    constexpr int I0 = 16 * 64, I1 = I0 + 256, I2 = I1 + 256, I3 = I2 + 256, I4 = I3 + 16 * 88, I5 = I4 + 44 * 16;
    LAS float* scr = (LAS float*)(lds + (threadIdx.x >> 6) * 16896); const int lane_ = threadIdx.x & 63;
    for (int it = gw; it < I5; it += ngw) {
        if (it < I0) wt_item(p.w_in, D, NIN, 4096, WINO, MapOff{NST}, scr, it, lane_);
        else if (it < I1) wt_item(p.w_bg, D, D, D, WBG, MapOff{0}, scr, it - I0, lane_);
        else if (it < I2) wt_item(p.w_bm, D, D, D, WBM, MapOff{0}, scr, it - I1, lane_);
        else if (it < I3) wt_item(p.w_out, D, D, D, WOUT, MapOff{0}, scr, it - I2, lane_);
        else if (it < I4) wt_item(p.w_up, D, 2 * DFF, 2 * DFF, WUP, MapUp{}, scr, it - I3, lane_);
        else wt_item(p.w_down, DFF, D, D, WDOWN, MapOff{0}, scr, it - I4, lane_); }
}

__device__ __forceinline__ void phase_scan(const P& p, int bid, int nblk, LAS unsigned char* lds, float* smem) {
#pragma unroll 1
    for (int vb = bid; vb < 256; vb += nblk) { const int xcd = vb & 7, li = vb >> 3; if (li < 16) { gdn_scan2(p, xcd * 16 + li, lds); __syncthreads(); } }
    if (nblk == 256 && (bid >> 3) < 16) {
        if (threadIdx.x == 0) { unsigned* cnt = (unsigned*)(p.ws + WS_CTL + 49152);
            __hip_atomic_fetch_add(cnt, 1u, __ATOMIC_RELEASE, __HIP_MEMORY_SCOPE_AGENT);
            while (__hip_atomic_load(cnt, __ATOMIC_ACQUIRE, __HIP_MEMORY_SCOPE_AGENT) < 128u) __builtin_amdgcn_s_sleep(16); }
        __syncthreads();
        const int gi = (bid & 7) * 16 + (bid >> 3);
        late_weights(p, gi * NWAVES + (int)(threadIdx.x >> 6), 128 * NWAVES, lds);
        __syncthreads();
    }
#pragma unroll 1
    for (int vb = bid; vb < 256; vb += nblk) { const int xcd = vb & 7, li = vb >> 3; if (li >= 16) { ml_scan2(p, xcd * 16 + (li - 16), lds); __syncthreads(); } }
    if (nblk == 256 && (bid >> 3) >= 16) { phase_shw(p, (bid & 7) * 16 + ((bid >> 3) - 16), 128, smem); __syncthreads(); }
}

#define XB_TMO      128
#define XB_XCNT(j)  (256  + 64 * (j))
#define XB_XSUB(j)  (1280 + 64 * (j))
#define XB_XGEN(j)  (2304 + 64 * (j))
#define XB_TOP      3328
#define XB_TOPGEN   3392
#define XCD_BAR_WORDS 3456
#define XB_SPIN_CAP (1u << 18)

__device__ __forceinline__ unsigned xb_ld(unsigned* p)              { return __hip_atomic_load(p, __ATOMIC_RELAXED, __HIP_MEMORY_SCOPE_AGENT); }
__device__ __forceinline__ unsigned xb_add(unsigned* p, unsigned v) { return __hip_atomic_fetch_add(p, v, __ATOMIC_RELAXED, __HIP_MEMORY_SCOPE_AGENT); }
__device__ __forceinline__ unsigned xb_xcc_id() { return (unsigned)__builtin_amdgcn_s_getreg((3 << 11) | 20) & 0xFu; }
#define XB_SPIN(cond, bar) do { unsigned _sp = 0; while (cond) { __builtin_amdgcn_s_sleep(1); \
    if ((++_sp & 255u) == 0u) { if (xb_ld(&(bar)[XB_TMO])) break; if (_sp > XB_SPIN_CAP) { atomicAdd(&(bar)[XB_TMO], 1u); break; } } } } while (0)

struct XcdBarrier {
    unsigned* bar; unsigned x;
    volatile LAS unsigned* st;
};

__device__ __forceinline__ XcdBarrier xcd_barrier_post(unsigned* bar, volatile LAS unsigned* st) {
    XcdBarrier b; b.bar = bar; b.x = xb_xcc_id(); b.st = st;
    if (threadIdx.x == 0) (void)xb_add(&bar[XB_XCNT(b.x)], 1u);
    return b;
}
__device__ __forceinline__ void xcd_barrier_complete(unsigned* bar, unsigned x, unsigned& nloc, unsigned& nx) {
    const unsigned G = gridDim.x * gridDim.y * gridDim.z;
    unsigned sum, cnt, mine, sp = 0u;
    for (;;) {
        sum = 0u; cnt = 0u; mine = 0u;
#pragma unroll
        for (unsigned j = 0; j < 16; ++j) { const unsigned c = xb_ld(&bar[XB_XCNT(j)]); sum += c; cnt += (c > 0u) ? 1u : 0u; mine = (j == x) ? c : mine; }
        if (sum == G) break;
        __builtin_amdgcn_s_sleep(1);
        if ((++sp & 255u) == 0u) { if (xb_ld(&bar[XB_TMO])) break; if (sp > XB_SPIN_CAP) { atomicAdd(&bar[XB_TMO], 1u); break; } }
    }
    nloc = mine > 0u ? mine : 1u; nx = cnt > 0u ? cnt : 1u;
}

__device__ __forceinline__ void xcd_barrier(const XcdBarrier& b) {
    asm volatile("s_waitcnt vmcnt(0)" ::: "memory");
    __syncthreads();
    if (threadIdx.x == 0) {
        unsigned* bar = b.bar;
        __builtin_amdgcn_s_waitcnt(0);
        unsigned nloc = b.st[0], nx = b.st[1];
        if (nloc == 0u) { xcd_barrier_complete(bar, b.x, nloc, nx); b.st[0] = nloc; b.st[1] = nx; }
        const unsigned old = xb_add(&bar[XB_XSUB(b.x)], 1u);
        const unsigned gen = old / nloc;
        if (old + 1u == (gen + 1u) * nloc) {
            __builtin_amdgcn_fence(__ATOMIC_RELEASE, "agent");
            asm volatile("s_waitcnt vmcnt(0)" ::: "memory");
            const unsigned og = xb_add(&bar[XB_TOP], 1u);
            const unsigned tg = og / nx;
            if (og + 1u == (tg + 1u) * nx) xb_add(&bar[XB_TOPGEN], 1u);
            else XB_SPIN(xb_ld(&bar[XB_TOPGEN]) == tg, bar);
            __builtin_amdgcn_fence(__ATOMIC_ACQUIRE, "agent");
            xb_add(&bar[XB_XGEN(b.x)], 1u);
            asm volatile("s_waitcnt vmcnt(0)" ::: "memory");
        } else {
            XB_SPIN(xb_ld(&bar[XB_XGEN(b.x)]) == gen, bar);
            __builtin_amdgcn_fence(__ATOMIC_ACQUIRE, "agent");
            asm volatile("s_waitcnt vmcnt(0)" ::: "memory");
        }
    }
    __syncthreads();
}

template <class E>
__device__ __forceinline__ void run_gemm(LAS unsigned char* lds, const bf16_t* A, const bf16_t* Bt, int M, int N, int K, const E& e) {
    pg8::Gemm g{A, Bt, M, N, K}; pg8::StaticOrder S; S.init(M, N, (int)gridDim.x, (int)blockIdx.x);
    pg8::gemm_phase<E, pg8::StaticOrder, true, true>(lds, g, S, e);
}

__global__ void __launch_bounds__(NTHREADS, 2) mega(Args args) {
    extern __shared__ __attribute__((aligned(16))) unsigned char lds_raw[];
    LAS unsigned char* lds = (LAS unsigned char*)lds_raw;
    float* smem = (float*)lds_raw;
    const P& p = args.p;
    unsigned char* ws = p.ws;
    const int bid = blockIdx.x, nblk = gridDim.x;
    const int gw = bid * NWAVES + (threadIdx.x >> 6), ngw = nblk * NWAVES;
    bf16_t* HX = (bf16_t*)(ws + WS_HX); bf16_t* QKV = (bf16_t*)(ws + WS_QKV); bf16_t* ML = (bf16_t*)(ws + WS_ML);
    float* GATES = (float*)(ws + WS_GATES); bf16_t* HALO = (bf16_t*)(ws + WS_HALO); float* MOD = (float*)(ws + WS_MOD);
    bf16_t* O = (bf16_t*)p.out; bf16_t* HM = O + (size_t)MX * 1024;
    bf16_t* HXB = (bf16_t*)(ws + WS_HXB); bf16_t* Z = (bf16_t*)(ws + WS_Z); bf16_t* TMP = (bf16_t*)(ws + WS_TMP); bf16_t* MERGED = (bf16_t*)(ws + WS_MERGED);
    bf16_t* HX2 = (bf16_t*)(ws + WS_HX2); bf16_t* U = (bf16_t*)(ws + WS_U); bf16_t* ACT = (bf16_t*)(ws + WS_ACT);
    bf16_t* WINS = (bf16_t*)(ws + WS_WINS); bf16_t* WINO = (bf16_t*)(ws + WS_WINO); bf16_t* WBG = (bf16_t*)(ws + WS_WBG); bf16_t* WBM = (bf16_t*)(ws + WS_WBM);
    bf16_t* WOUT = (bf16_t*)(ws + WS_WOUT); bf16_t* WUP = (bf16_t*)(ws + WS_WUP); bf16_t* WDOWN = (bf16_t*)(ws + WS_WDOWN);
    const int lo = args.ph_lo, hi = args.ph_hi;
    volatile LAS unsigned* misc = (volatile LAS unsigned*)(lds + LDS_MISC);
    if (threadIdx.x < 32) misc[threadIdx.x] = 0u;
    __syncthreads();
    XcdBarrier xbar = xcd_barrier_post((unsigned*)(ws + WS_CTL), misc);
#define IN(k) (lo <= (k) && (k) < hi)
#define SEAM(k) do { if (IN(k)) { GRID_SYNC(); } } while (0)
#define GRID_SYNC() xcd_barrier(xbar)
    if (IN(0)) { phase_mod(p, bid, nblk, smem); __syncthreads(); wt_convert(p.w_in, D, NIN, NSTP, WINS, MapInS{}, lds, gw, ngw); } SEAM(0);
    if (IN(1)) { phase_norm(p, 1, 0, MT, HX, bid, nblk); } SEAM(1);
    if (IN(2)) { run_gemm(lds, HX, WINS, MT, NSTP, D, epi::Zs{QKV, ML, GATES, HALO}); } SEAM(2);
    if (IN(3)) { phase_prep2(p, bid, nblk, lds); } SEAM(3);
    if (IN(4)) { phase_scan(p, bid, nblk, lds, smem); } SEAM(4);
    if (IN(5)) { phase_norm(p, 1, 0, MX, HXB, bid, nblk);
                 { float* rowss_ = (float*)(ws + WS_ROWSS); for (int i = bid * NTHREADS + (int)threadIdx.x; i < MX; i += nblk * NTHREADS) rowss_[i] = 0.f; }
                 if (nblk != 256) { phase_shw(p, bid, nblk, smem); __syncthreads(); late_weights(p, gw, ngw, lds); } } SEAM(5);
    if (IN(6)) { run_gemm(lds, HXB, WINO, MX, 4096, D, epi::Zo{Z, O, HM, p.gdn_norm_w, p.ml_norm_w, (LAS float*)(lds + 131072)}); } SEAM(6);
    if (IN(8)) { run_gemm(lds, O, WBG, MX, D, D, epi::Br1{Z, TMP}); asm volatile("s_waitcnt vmcnt(0)" ::: "memory"); __syncthreads(); }
    if (IN(9)) { run_gemm(lds, HM, WBM, MX, D, D, epi::Br2{Z, TMP, MERGED}); } SEAM(9);
    if (IN(10)) { run_gemm(lds, MERGED, WOUT, MX, D, D, epi::ResN{p.x, MOD, p.out, HX2, p.norm2_w, (float*)(ws + WS_ROWSS)}); } SEAM(10);
    if (IN(12)) { run_gemm(lds, HX2, WUP, MX, UPA_N, D, epi::Up{U, UPA_N, (const float*)(ws + WS_ROWSS), (const float*)(ws + WS_SHW), 0}); } SEAM(12);
    if (IN(13)) { phase_convact<8>(p, 0, UPA_C, bid, nblk, lds); } SEAM(13);
    if (IN(14)) { run_gemm(lds, HX2, WUP + (size_t)UPA_N * D, MX, UPB_N, D, epi::Up{U, UPB_N, (const float*)(ws + WS_ROWSS), (const float*)(ws + WS_SHW), UPA_N}); } SEAM(14);
    if (IN(15)) { phase_convact<8>(p, UPA_C, UPB_C, bid, nblk, lds); } SEAM(15);
    if (IN(16)) { run_gemm(lds, ACT, WDOWN, MX, D, DFF, epi::Res{p.out, MOD, 5, p.out}); } SEAM(16);
    if (IN(17)) { phase_final(p, bid, nblk); }
}

extern "C" void kernel_launch(void* const* d_in, const int* in_sizes, int n_in, void* d_out, int out_size, void* d_ws, size_t ws_size, hipStream_t stream) {
    static int grid = 0;
    if (grid == 0) {
        int dev = 0, cus = 0, per_cu = 0;
        (void)hipGetDevice(&dev); (void)hipDeviceGetAttribute(&cus, hipDeviceAttributeMultiprocessorCount, dev);
        (void)hipFuncSetAttribute((const void*)mega, hipFuncAttributeMaxDynamicSharedMemorySize, LDS_BYTES);
        (void)hipOccupancyMaxActiveBlocksPerMultiprocessor(&per_cu, (const void*)mega, NTHREADS, LDS_BYTES);
        if (per_cu < 1) per_cu = 1;
        if (per_cu > 1) per_cu = 1;
        grid = (cus > 0 ? cus : 256) * per_cu;
    }
    Args a{};
    const float** f = (const float**)&a.p;
    for (int i = 0; i < 23; ++i) f[i] = (const float*)d_in[i];
    a.p.out = (float*)d_out; a.p.ws = (unsigned char*)d_ws;
    a.ph_lo = 0; a.ph_hi = 18;
    (void)hipMemsetAsync((char*)d_ws + WS_CTL, 0, 65536, stream);
    void* args[] = {&a};
    hipError_t e = hipLaunchCooperativeKernel((const void*)mega, dim3(grid), dim3(NTHREADS), args, LDS_BYTES, stream);
    if (e != hipSuccess) fprintf(stderr, "cooperative launch failed: %s (grid %d)\n", hipGetErrorString(e), grid);
}
```

```cpp
#include <hip/hip_runtime.h>
#include <hip/hip_cooperative_groups.h>
#include <cstdint>
#include <cstdio>

namespace pg8 {
#define PG8_LAS __attribute__((address_space(3)))
typedef unsigned short bf16_t;
typedef short bf16x8 __attribute__((ext_vector_type(8)));
typedef float f32x4 __attribute__((ext_vector_type(4)));
typedef unsigned u32x4 __attribute__((ext_vector_type(4)));
constexpr int BM = 256, BK = 64, HALF = 128, HTB = HALF * BK * 2  , STAGE_BYTES = 8 * HTB, NXCD = 8, WGM = 8;

__host__ __device__ __forceinline__ int lds_byte(int r, int c) { const int st = (r >> 4) * 2 + (c >> 5), rr = r & 15, cc = c & 31, ob = rr * 64 + cc * 2; return st * 1024 + (ob ^ (((ob >> 9) & 1) << 5)); }
__host__ __device__ __forceinline__ void stage_rc(int b, int& R, int& C) { const int st = b / 1024, sb = b % 1024, swz = sb ^ (((sb >> 9) & 1) << 5); R = (st >> 1) * 16 + swz / 64; C = (st & 1) * 32 + (swz % 64) / 2; }
__host__ __device__ __forceinline__ int perm32(int rho) { const int n = rho >> 4, i = rho & 15; return 8 * (i >> 2) + 4 * n + (i & 3); }

struct Unit { int pm, pn; };
struct Gemm { const bf16_t* A; const bf16_t* Bt; int M, N, K; };

struct StaticOrder {
    int nM, nN, nwg, G, c;
    __host__ __device__ void init(int M, int N, int G_, int c_) { nM = M / BM; nN = N / BM; nwg = nM * nN; G = G_; c = c_; }
    __host__ __device__ bool next(int i, Unit& u) const {
        const long L = (long)i * G + c; if (L >= nwg) return false;
        int wgid = (int)L; { const int q = nwg / NXCD, r = nwg % NXCD, xcd = wgid % NXCD, off = wgid / NXCD; wgid = (xcd < r ? xcd * (q + 1) : r * (q + 1) + (xcd - r) * q) + off; }
        const int nig = WGM * nN, gid = wgid / nig, fm = gid * WGM, gsz = (nM - fm) < WGM ? (nM - fm) : WGM;
        u.pm = fm + ((wgid % nig) % gsz); u.pn = (wgid % nig) / gsz; return true;
    }
    __device__ __forceinline__ void a_ready(const Unit&) const {}
    __device__ __forceinline__ void done(const Unit&) const {}
};

__device__ __forceinline__ unsigned cvt_pk_bf16(float lo, float hi) { unsigned r; asm volatile("v_cvt_pk_bf16_f32 %0, %1, %2" : "=v"(r) : "v"(lo), "v"(hi)); return r; }
typedef float f32x2 __attribute__((ext_vector_type(2)));

template <class Epi, class Sched, bool ALIGN_EPI = false, bool SP2 = false>
__device__ __forceinline__ void gemm_phase(PG8_LAS unsigned char* lds, const Gemm g, const Sched& S, const Epi& E) {
    const int tid = threadIdx.x, wid = __builtin_amdgcn_readfirstlane(tid >> 6), lane = tid & 63, wr = wid >> 2, wc = wid & 3, fr = lane & 15, fq = lane >> 4;
    const int K = g.K, nt = K / BK;
    unsigned voffA[2], voffB[2];
#pragma unroll
    for (int i = 0; i < 2; ++i) { int R, C; stage_rc(tid * 16 + i * 8192, R, C); const int Rb = Epi::PERM ? ((R & ~31) + perm32(R & 31)) : R;
        voffA[i] = (unsigned)(R * K + C) * 2u; voffB[i] = (unsigned)(Rb * K + C) * 2u; }
    const size_t kstep = (size_t)(BK * 2);
    const size_t hstep = (size_t)HALF * K * 2;
    const size_t tstep = 2 * hstep;
    const unsigned ldsw = (unsigned)wid * 1024u;
    const int aoff = lds_byte(wr * 64 + fr, fq * 8), boff = lds_byte(wc * 32 + fr, fq * 8);
#define PG8_SA(b, h) (((b) * 2 + (h)) * HTB)
#define PG8_SB(b, h) ((4 + (b) * 2 + (h)) * HTB)
#define PG8_STAGE(bufoff, gbase, voff) do { _Pragma("unroll") for (int _i = 0; _i < 2; ++_i) \
        __builtin_amdgcn_global_load_lds((const unsigned*)((const char*)(gbase) + (voff)[_i]), (PG8_LAS unsigned*)(lds + (bufoff) + ldsw + _i * 8192), 16, 0, 0); } while (0)
#define PG8_LDA(dst, b, h) do { _Pragma("unroll") for (int m = 0; m < 4; ++m) _Pragma("unroll") for (int k = 0; k < 2; ++k) dst[m][k] = *(const PG8_LAS bf16x8*)(lds + PG8_SA(b, h) + aoff + m * 2048 + k * 1024); } while (0)
#define PG8_LDB(dst, b, h) do { _Pragma("unroll") for (int n = 0; n < 2; ++n) _Pragma("unroll") for (int k = 0; k < 2; ++k) dst[n][k] = *(const PG8_LAS bf16x8*)(lds + PG8_SB(b, h) + boff + n * 2048 + k * 1024); } while (0)
#define PG8_MMA(ai, bj, At, Bt) do { __builtin_amdgcn_s_setprio(1); _Pragma("unroll") for (int m = 0; m < 4; ++m) _Pragma("unroll") for (int n = 0; n < 2; ++n) _Pragma("unroll") for (int k = 0; k < 2; ++k) \
        acc[ai][bj][m][n] = __builtin_amdgcn_mfma_f32_16x16x32_bf16(Bt[n][k], At[m][k], acc[ai][bj][m][n], 0, 0, 0); __builtin_amdgcn_s_setprio(0); } while (0)
#define PG8_WAIT_V(n) asm volatile("s_waitcnt vmcnt(" #n ")" ::: "memory")
#define PG8_WAIT_L(n) asm volatile("s_waitcnt lgkmcnt(" #n ")" ::: "memory")
#define PG8_BAR __builtin_amdgcn_s_barrier()
#define PG8_SCHED __builtin_amdgcn_sched_barrier(0)
    Unit cur, nxt; int ui = 0;
    if (!S.next(0, cur)) return;
    f32x4 acc[2][2][4][2];
#pragma unroll
    for (int a = 0; a < 2; ++a)
#pragma unroll
        for (int b = 0; b < 2; ++b)
#pragma unroll
            for (int m = 0; m < 4; ++m)
#pragma unroll
                for (int n = 0; n < 2; ++n) acc[a][b][m][n] = (f32x4){0.f, 0.f, 0.f, 0.f};
    bf16x8 At[4][2], B0[2][2], B1[2][2];
    const char* cA = (const char*)g.A + (size_t)cur.pm * tstep; const char* cB = (const char*)g.Bt + (size_t)cur.pn * tstep;
    S.a_ready(cur);
    if constexpr (SP2) {
        PG8_STAGE(PG8_SB(0, 0), cB, voffB); PG8_STAGE(PG8_SB(0, 1), cB + hstep, voffB); PG8_STAGE(PG8_SA(0, 0), cA, voffA); PG8_STAGE(PG8_SA(0, 1), cA + hstep, voffA);
        if (wr == 1) PG8_BAR;
        PG8_WAIT_V(2); PG8_BAR;
        PG8_STAGE(PG8_SB(1, 0), cB + kstep, voffB); PG8_STAGE(PG8_SA(1, 0), cA + kstep, voffA); PG8_STAGE(PG8_SB(1, 1), cB + hstep + kstep, voffB);
        PG8_WAIT_V(6); PG8_BAR;
    } else {
        PG8_STAGE(PG8_SB(0, 0), cB, voffB); PG8_STAGE(PG8_SA(0, 0), cA, voffA); PG8_STAGE(PG8_SB(0, 1), cB + hstep, voffB); PG8_STAGE(PG8_SA(0, 1), cA + hstep, voffA);
        if (wr == 1) PG8_BAR;
        PG8_WAIT_V(4); PG8_BAR;
        PG8_STAGE(PG8_SB(1, 0), cB + kstep, voffB); PG8_STAGE(PG8_SA(1, 0), cA + kstep, voffA); PG8_STAGE(PG8_SB(1, 1), cB + hstep + kstep, voffB);
        PG8_WAIT_V(6); PG8_BAR;
    }
    for (;;) {
        const bool has_next = S.next(ui + 1, nxt);
        const char* nA = has_next ? (const char*)g.A + (size_t)nxt.pm * tstep : cA; const char* nB = has_next ? (const char*)g.Bt + (size_t)nxt.pn * tstep : cB;
        for (int t = 0; t < nt; t += 2) {
            const bool last = (t == nt - 2);
            const char* a1 = cA + (size_t)(t + 1) * kstep;
            const char* a2 = last ? nA : cA + (size_t)(t + 2) * kstep; const char* b2 = last ? nB : cB + (size_t)(t + 2) * kstep;
            const char* a3 = a2 + kstep; const char* b3 = b2 + kstep;
            if (last && has_next) S.a_ready(nxt);
            if constexpr (SP2) {
            PG8_LDB(B0, 0, 0); PG8_LDB(B1, 0, 1); PG8_SCHED; PG8_LDA(At, 0, 0); PG8_STAGE(PG8_SA(1, 1), a1 + hstep, voffA);
            PG8_WAIT_V(8); PG8_WAIT_L(0); PG8_BAR; PG8_MMA(0, 0, At, B0); PG8_MMA(0, 1, At, B1); PG8_BAR; PG8_SCHED;
            PG8_LDA(At, 0, 1); PG8_STAGE(PG8_SB(0, 0), b2, voffB); PG8_STAGE(PG8_SB(0, 1), b2 + hstep, voffB); PG8_STAGE(PG8_SA(0, 0), a2, voffA);
            PG8_WAIT_V(8); PG8_WAIT_L(0); PG8_BAR; PG8_MMA(1, 0, At, B0); PG8_MMA(1, 1, At, B1); PG8_BAR; PG8_SCHED;
            PG8_LDB(B0, 1, 0); PG8_LDB(B1, 1, 1); PG8_SCHED; PG8_LDA(At, 1, 0); PG8_STAGE(PG8_SA(0, 1), a2 + hstep, voffA);
            PG8_WAIT_V(8); PG8_WAIT_L(0); PG8_BAR; PG8_MMA(0, 0, At, B0); PG8_MMA(0, 1, At, B1); PG8_BAR; PG8_SCHED;
            PG8_LDA(At, 1, 1); PG8_STAGE(PG8_SB(1, 0), b3, voffB); PG8_STAGE(PG8_SB(1, 1), b3 + hstep, voffB); PG8_STAGE(PG8_SA(1, 0), a3, voffA);
            PG8_WAIT_V(8); PG8_WAIT_L(0); PG8_BAR; PG8_MMA(1, 0, At, B0); PG8_MMA(1, 1, At, B1); PG8_BAR; PG8_SCHED;
            } else {
            PG8_LDB(B0, 0, 0); PG8_SCHED; PG8_LDA(At, 0, 0); PG8_STAGE(PG8_SA(1, 1), a1 + hstep, voffA);
            PG8_WAIT_L(8); PG8_BAR; PG8_WAIT_L(0); PG8_MMA(0, 0, At, B0); PG8_BAR; PG8_SCHED;
            PG8_LDB(B1, 0, 1); PG8_STAGE(PG8_SB(0, 0), b2, voffB);
            PG8_BAR; PG8_WAIT_L(0); PG8_MMA(0, 1, At, B1); PG8_BAR;
            PG8_LDA(At, 0, 1); PG8_STAGE(PG8_SA(0, 0), a2, voffA);
            PG8_BAR; PG8_WAIT_L(0); PG8_MMA(1, 0, At, B0); PG8_BAR; PG8_SCHED;
            PG8_STAGE(PG8_SB(0, 1), b2 + hstep, voffB);
            PG8_WAIT_V(6); PG8_BAR; PG8_MMA(1, 1, At, B1); PG8_BAR;
            PG8_LDB(B0, 1, 0); PG8_SCHED; PG8_LDA(At, 1, 0); PG8_STAGE(PG8_SA(0, 1), a2 + hstep, voffA);
            PG8_WAIT_L(8); PG8_BAR; PG8_WAIT_L(0); PG8_MMA(0, 0, At, B0); PG8_BAR; PG8_SCHED;
            PG8_LDB(B1, 1, 1); PG8_STAGE(PG8_SB(1, 0), b3, voffB);
            PG8_BAR; PG8_WAIT_L(0); PG8_MMA(0, 1, At, B1); PG8_BAR;
            PG8_LDA(At, 1, 1); PG8_STAGE(PG8_SA(1, 0), a3, voffA);
            PG8_BAR; PG8_WAIT_L(0); PG8_MMA(1, 0, At, B0); PG8_BAR; PG8_SCHED;
            PG8_STAGE(PG8_SB(1, 1), b3 + hstep, voffB);
            PG8_WAIT_V(6); PG8_BAR; PG8_MMA(1, 1, At, B1); PG8_BAR;
            }
        }
        if constexpr (ALIGN_EPI) { if (wr == 0) PG8_BAR; }
        if constexpr (!Epi::AFTER_DRAIN) { E(acc, cur, wr, wc, fr, fq); S.done(cur); }
        if (!has_next) break;
#pragma unroll
        for (int a = 0; a < 2; ++a)
#pragma unroll
            for (int b = 0; b < 2; ++b)
#pragma unroll
                for (int m = 0; m < 4; ++m)
#pragma unroll
                    for (int n = 0; n < 2; ++n) acc[a][b][m][n] = (f32x4){0.f, 0.f, 0.f, 0.f};
        cur = nxt; cA = nA; cB = nB; ++ui;
        if constexpr (ALIGN_EPI) { if (wr == 1) PG8_BAR; }
    }
    PG8_WAIT_V(0);
    if constexpr (!ALIGN_EPI) { if (wr == 0) PG8_BAR; }
    PG8_BAR;
    if constexpr (Epi::AFTER_DRAIN) { E.fused(acc, cur, wr, wc, fr, fq, lds, wid, lane); S.done(cur); }
#undef PG8_SA
#undef PG8_SB
#undef PG8_STAGE
#undef PG8_LDA
#undef PG8_LDB
#undef PG8_MMA
#undef PG8_WAIT_V
#undef PG8_WAIT_L
#undef PG8_BAR
#undef PG8_SCHED
}
}


typedef unsigned short bf16_t;
typedef float f32x4 __attribute__((ext_vector_type(4)));
typedef unsigned u32x4 __attribute__((ext_vector_type(4)));
typedef unsigned u32x2 __attribute__((ext_vector_type(2)));
#define LAS __attribute__((address_space(3)))

constexpr int D = 1024, NB = 4, T = 8192, CT = 256, MX = NB * T, MC = NB * CT, MT = MX + MC;
constexpr int DFF = 2816, NMOD = 6;
constexpr int NIN = 9264, NST = 5168, NSTP = 5376;
constexpr float EPS = 1e-6f, GCAP = 15.0f;
constexpr float QSCALE = 0.08838834764831845f;
constexpr int UPA_N = 2560, UPA_C = 1280, UPB_N = 3072, UPB_C = 1536;

constexpr size_t MiB = 1u << 20;
constexpr size_t WS_CTL = 0, WS_MOD = 1 * MiB, WS_GATES = 2 * MiB, WS_HALO = 11 * MiB, WS_SCAL = 18 * MiB;
constexpr size_t WS_QKV = 30 * MiB, WS_ML = 228 * MiB, WS_HX = 360 * MiB, WS_WINS = 492 * MiB;
constexpr size_t WS_GSC = 18 * MiB, WS_TB = 360 * MiB, WS_ATTN = 426 * MiB, WS_MLS = 503 * MiB;
constexpr size_t WS_HXB = 2 * MiB, WS_WINO = 68 * MiB, WS_WBG = 76 * MiB, WS_WBM = 78 * MiB, WS_WOUT = 80 * MiB, WS_WUP = 82 * MiB, WS_WDOWN = 93 * MiB;
constexpr size_t WS_Z = 110 * MiB, WS_TMP = 366 * MiB, WS_MERGED = 366 * MiB;
constexpr size_t WS_ROWSS = 1 * MiB + 256 * 1024, WS_SHW = 1 * MiB + 512 * 1024;
constexpr size_t WS_HX2 = 2 * MiB, WS_U = 110 * MiB, WS_ACT = 302 * MiB;

constexpr int NWAVES = 8, NTHREADS = 512;
constexpr int LDS_BYTES = 163840;
constexpr int LDS_MISC = 163712;

struct P {
    const float *x, *c, *ctx, *c_ctx, *w_ada, *b_ada, *norm1_w, *w_in, *gdn_conv, *gdn_a_log, *gdn_dt_bias, *gdn_norm_w,
        *ml_igate_b, *ml_fgate_b, *ml_norm_w, *w_bg, *w_bm, *w_out, *norm2_w, *w_up, *ffn_conv, *w_down, *norm_out_w;
    float* out; unsigned char* ws;
};
struct Args { P p; int ph_lo, ph_hi; };

__device__ __forceinline__ float bf2f(bf16_t v) { return __uint_as_float((unsigned)v << 16); }
__device__ __forceinline__ bf16_t f2bf(float f) { unsigned u = __float_as_uint(f); return (bf16_t)((u + 0x7fffu + ((u >> 16) & 1u)) >> 16); }
__device__ __forceinline__ unsigned pk2(float lo, float hi) { return (unsigned)f2bf(lo) | ((unsigned)f2bf(hi) << 16); }
__device__ __forceinline__ float sigmoidf_(float x) { return 1.0f / (1.0f + __expf(-x)); }
__device__ __forceinline__ float siluf_(float x) { return x / (1.0f + __expf(-x)); }
__device__ __forceinline__ float silu_fast(float x) { return x * __builtin_amdgcn_rcpf(1.0f + __expf(-x)); }
__device__ __forceinline__ float softplusf_(float x) { return x > 20.f ? x : log1pf(expf(x)); }
__device__ __forceinline__ float softcapf_(float x) { return GCAP * tanhf(x * (1.0f / GCAP)); }
__device__ __forceinline__ float wave_sum(float v) {
#pragma unroll
    for (int o = 1; o < 64; o <<= 1) v += __shfl_xor(v, o);
    return v;
}
__device__ __forceinline__ int row_modv(int r) { return r < MX ? (r >> 13) : 4; }
__device__ __forceinline__ f32x4 bf4_to_f32(uint2 v) { return (f32x4){__uint_as_float(v.x << 16), __uint_as_float(v.x & 0xffff0000u), __uint_as_float(v.y << 16), __uint_as_float(v.y & 0xffff0000u)}; }

namespace epi {
using pg8::Unit; using pg8::cvt_pk_bf16;
typedef float f32x4 __attribute__((ext_vector_type(4)));
__device__ __forceinline__ u32x4 pack8(const f32x4 a, const f32x4 b) { u32x4 w; w.x = cvt_pk_bf16(a[0], a[1]); w.y = cvt_pk_bf16(a[2], a[3]); w.z = cvt_pk_bf16(b[0], b[1]); w.w = cvt_pk_bf16(b[2], b[3]); return w; }
__device__ __forceinline__ f32x4 silu4(f32x4 v) { return (f32x4){siluf_(v[0]), siluf_(v[1]), siluf_(v[2]), siluf_(v[3])}; }
__device__ __forceinline__ f32x4 sigm4(f32x4 v) { return (f32x4){sigmoidf_(v[0]), sigmoidf_(v[1]), sigmoidf_(v[2]), sigmoidf_(v[3])}; }

struct Zs {
    static constexpr bool PERM = true, AFTER_DRAIN = false;
    bf16_t* qkv; bf16_t* ml; float* gates; bf16_t* halo;
    __device__ __forceinline__ void operator()(const f32x4 (&acc)[2][2][4][2], const Unit& u, int wr, int wc, int fr, int fq) const {
        const int row0 = u.pm * 256 + wr * 64 + fr, c8 = wc * 32 + 8 * fq;
        if (u.pn < 20) {
            bf16_t* pb[2]; int ld2[2]; const int col0 = u.pn * 256 + c8;
#pragma unroll
            for (int bj = 0; bj < 2; ++bj) {
                if (u.pn < 12) { pb[bj] = qkv + (size_t)(2 * u.pn + bj) * MT * 128 + c8; ld2[bj] = 128; }
                else { const int cm = (u.pn - 12) * 256 + bj * 128;
                    if (cm < 1024) { pb[bj] = ml + (size_t)(cm >> 7) * MT * 128 + c8; ld2[bj] = 128; }
                    else { pb[bj] = ml + (size_t)8 * MT * 128 + (size_t)((cm - 1024) >> 8) * MT * 256 + ((cm - 1024) & 255) + c8; ld2[bj] = 256; } } }
#pragma unroll
            for (int ai = 0; ai < 2; ++ai)
#pragma unroll
                for (int m = 0; m < 4; ++m) { const int row = row0 + ai * 128 + m * 16;
#pragma unroll
                    for (int bj = 0; bj < 2; ++bj) { const u32x4 w = pack8(acc[ai][bj][m][0], acc[ai][bj][m][1]);
                        *(u32x4*)(pb[bj] + (size_t)row * ld2[bj]) = w;
                        if (u.pn < 12) {
                            if (m == 0 && fr == 0) *(u32x4*)(halo + ((size_t)(row >> 6) * 2 + 0) * 3072 + col0 + bj * 128) = w;
                            if (m == 3 && fr == 15) *(u32x4*)(halo + ((size_t)(row >> 6) * 2 + 1) * 3072 + col0 + bj * 128) = w; } } }
        } else {
            if (c8 < 48) {
#pragma unroll
                for (int ai = 0; ai < 2; ++ai)
#pragma unroll
                    for (int m = 0; m < 4; ++m) { const int row = row0 + ai * 128 + m * 16; float* g = gates + (size_t)row * 64 + c8;
                        *(f32x4*)g = acc[ai][0][m][0]; *(f32x4*)(g + 4) = acc[ai][0][m][1]; }
            }
        }
    }
};
struct Zo {
    static constexpr bool PERM = true, AFTER_DRAIN = false;
    bf16_t* g2; bf16_t* O; bf16_t* HM; const float* gw; const float* mw; LAS float* scr;
    __device__ __forceinline__ void operator()(const f32x4 (&acc)[2][2][4][2], const Unit& u, int wr, int wc, int fr, int fq) const {
        const int row0 = u.pm * 256 + wr * 64 + fr, c8 = wc * 32 + 8 * fq;
        if (u.pn >= 8) {
            const int col0 = (u.pn - 8) * 256 + c8;
#pragma unroll
            for (int ai = 0; ai < 2; ++ai)
#pragma unroll
                for (int m = 0; m < 4; ++m) { const int row = row0 + ai * 128 + m * 16;
#pragma unroll
                    for (int bj = 0; bj < 2; ++bj) *(u32x4*)(g2 + (size_t)row * 2048 + col0 + bj * 128) = pack8(sigm4(acc[ai][bj][m][0]), sigm4(acc[ai][bj][m][1])); }
            return;
        }
        const bool isg = u.pn < 4; bf16_t* X = isg ? O : HM; const int xc0 = (isg ? u.pn : u.pn - 4) * 256 + c8;
#pragma unroll
        for (int ai = 0; ai < 2; ++ai)
#pragma unroll
            for (int m = 0; m < 4; ++m) { const int rl = ai * 128 + wr * 64 + m * 16 + fr; const bf16_t* xp = X + (size_t)(u.pm * 256 + rl) * 1024 + xc0;
#pragma unroll
                for (int bj = 0; bj < 2; ++bj) { const u32x4 xv = *(const u32x4*)(xp + bj * 128);
                    const f32x4 x0 = bf4_to_f32(make_uint2(xv.x, xv.y)), x1 = bf4_to_f32(make_uint2(xv.z, xv.w));
                    float ss = x0[0] * x0[0] + x0[1] * x0[1] + x0[2] * x0[2] + x0[3] * x0[3] + x1[0] * x1[0] + x1[1] * x1[1] + x1[2] * x1[2] + x1[3] * x1[3];
                    ss += __shfl_xor(ss, 16); ss += __shfl_xor(ss, 32);
                    if (fq == 0) scr[rl * 8 + wc * 2 + bj] = ss; } }
        asm volatile("s_waitcnt lgkmcnt(0)" ::: "memory"); __builtin_amdgcn_s_barrier(); asm volatile("" ::: "memory");
#pragma unroll
        for (int ai = 0; ai < 2; ++ai)
#pragma unroll
            for (int m = 0; m < 4; ++m) { const int rl = ai * 128 + wr * 64 + m * 16 + fr; bf16_t* xp = X + (size_t)(u.pm * 256 + rl) * 1024 + xc0;
                const f32x4 p0 = *(const LAS f32x4*)(scr + rl * 8), p1 = *(const LAS f32x4*)(scr + rl * 8 + 4);
                const float t0 = (p0[0] + p0[2]) + (p1[0] + p1[2]), t1 = (p0[1] + p0[3]) + (p1[1] + p1[3]);
                const float rs0 = isg ? rsqrtf(t0 * (1.0f / 128.f) + EPS) : rsqrtf((t0 + t1) * (1.0f / 256.f) + EPS), rs1 = isg ? rsqrtf(t1 * (1.0f / 128.f) + EPS) : rs0;
#pragma unroll
                for (int bj = 0; bj < 2; ++bj) { const u32x4 xv = *(const u32x4*)(xp + bj * 128);
                    const f32x4 x0 = bf4_to_f32(make_uint2(xv.x, xv.y)), x1 = bf4_to_f32(make_uint2(xv.z, xv.w));
                    const float* wp = isg ? gw + c8 : mw + (u.pn - 4) * 256 + bj * 128 + c8;
                    const f32x4 w0 = *(const f32x4*)wp, w1 = *(const f32x4*)(wp + 4);
                    const float rs = bj ? rs1 : rs0;
                    const f32x4 a0 = isg ? silu4(acc[ai][bj][m][0]) : sigm4(acc[ai][bj][m][0]), a1 = isg ? silu4(acc[ai][bj][m][1]) : sigm4(acc[ai][bj][m][1]);
                    *(u32x4*)(xp + bj * 128) = pack8(x0 * rs * w0 * a0, x1 * rs * w1 * a1); } }
    }
};
struct Br1 {
    static constexpr bool PERM = true, AFTER_DRAIN = false;
    const bf16_t* z; bf16_t* tmp;
    __device__ __forceinline__ void operator()(const f32x4 (&acc)[2][2][4][2], const Unit& u, int wr, int wc, int fr, int fq) const {
        const int row0 = u.pm * 256 + wr * 64 + fr, col0 = u.pn * 256 + wc * 32 + 8 * fq;
#pragma unroll
        for (int ai = 0; ai < 2; ++ai)
#pragma unroll
            for (int m = 0; m < 4; ++m) { const int row = row0 + ai * 128 + m * 16;
#pragma unroll
                for (int bj = 0; bj < 2; ++bj) { const int col = col0 + bj * 128;
                    const uint4 gz = *(const uint4*)(z + (size_t)row * 2048 + col);
                    const f32x4 g0 = bf4_to_f32(make_uint2(gz.x, gz.y)), g1 = bf4_to_f32(make_uint2(gz.z, gz.w));
                    *(u32x4*)(tmp + (size_t)row * D + col) = pack8(g0 * acc[ai][bj][m][0], g1 * acc[ai][bj][m][1]); } }
    }
};
struct Br2 {
    static constexpr bool PERM = true, AFTER_DRAIN = false;
    const bf16_t* z; const bf16_t* tmp; bf16_t* merged;
    __device__ __forceinline__ void operator()(const f32x4 (&acc)[2][2][4][2], const Unit& u, int wr, int wc, int fr, int fq) const {
        const int row0 = u.pm * 256 + wr * 64 + fr, col0 = u.pn * 256 + wc * 32 + 8 * fq;
#pragma unroll
        for (int ai = 0; ai < 2; ++ai)
#pragma unroll
            for (int m = 0; m < 4; ++m) { const int row = row0 + ai * 128 + m * 16;
#pragma unroll
                for (int bj = 0; bj < 2; ++bj) { const int col = col0 + bj * 128;
                    const uint4 gz = *(const uint4*)(z + (size_t)row * 2048 + 1024 + col), tz = *(const uint4*)(tmp + (size_t)row * D + col);
                    const f32x4 g0 = bf4_to_f32(make_uint2(gz.x, gz.y)), g1 = bf4_to_f32(make_uint2(gz.z, gz.w));
                    const f32x4 t0 = bf4_to_f32(make_uint2(tz.x, tz.y)), t1 = bf4_to_f32(make_uint2(tz.z, tz.w));
                    *(u32x4*)(merged + (size_t)row * D + col) = pack8(t0 + g0 * acc[ai][bj][m][0], t1 + g1 * acc[ai][bj][m][1]); } }
    }
};
struct Res {
    static constexpr bool PERM = true, AFTER_DRAIN = false;
    const float* base; const float* mod; int modidx; float* out;
    __device__ __forceinline__ void operator()(const f32x4 (&acc)[2][2][4][2], const Unit& u, int wr, int wc, int fr, int fq) const {
        const int row0 = u.pm * 256 + wr * 64 + fr, col0 = u.pn * 256 + wc * 32 + 8 * fq;
        const float* mrow = mod + ((u.pm * 256) >> 13) * (NMOD * D) + modidx * D;
#pragma unroll
        for (int ai = 0; ai < 2; ++ai)
#pragma unroll
            for (int m = 0; m < 4; ++m) { const int row = row0 + ai * 128 + m * 16;
#pragma unroll
                for (int bj = 0; bj < 2; ++bj) { const int col = col0 + bj * 128;
                    const f32x4 b0 = *(const f32x4*)(base + (size_t)row * D + col), b1 = *(const f32x4*)(base + (size_t)row * D + col + 4);
                    const f32x4 g0 = *(const f32x4*)(mrow + col), g1 = *(const f32x4*)(mrow + col + 4);
                    *(f32x4*)(out + (size_t)row * D + col) = b0 + g0 * acc[ai][bj][m][0]; *(f32x4*)(out + (size_t)row * D + col + 4) = b1 + g1 * acc[ai][bj][m][1]; } }
    }
};
struct ResN {
    static constexpr bool PERM = true, AFTER_DRAIN = false;
    const float* base; const float* mod; float* out; bf16_t* an; const float* nw; float* rowss;
    __device__ __forceinline__ void operator()(const f32x4 (&acc)[2][2][4][2], const Unit& u, int wr, int wc, int fr, int fq) const {
        const int row0 = u.pm * 256 + wr * 64 + fr, col0 = u.pn * 256 + wc * 32 + 8 * fq;
        const float* mb = mod + ((u.pm * 256) >> 13) * (NMOD * D);
#pragma unroll
        for (int ai = 0; ai < 2; ++ai)
#pragma unroll
            for (int m = 0; m < 4; ++m) { const int row = row0 + ai * 128 + m * 16; float ss = 0.f;
#pragma unroll
                for (int bj = 0; bj < 2; ++bj) { const int col = col0 + bj * 128;
                    const f32x4 b0 = *(const f32x4*)(base + (size_t)row * D + col), b1 = *(const f32x4*)(base + (size_t)row * D + col + 4);
                    const f32x4 g0 = *(const f32x4*)(mb + 2 * D + col), g1 = *(const f32x4*)(mb + 2 * D + col + 4);
                    const f32x4 xa = b0 + g0 * acc[ai][bj][m][0], xb = b1 + g1 * acc[ai][bj][m][1];
                    *(f32x4*)(out + (size_t)row * D + col) = xa; *(f32x4*)(out + (size_t)row * D + col + 4) = xb;
                    ss += xa[0] * xa[0] + xa[1] * xa[1] + xa[2] * xa[2] + xa[3] * xa[3] + xb[0] * xb[0] + xb[1] * xb[1] + xb[2] * xb[2] + xb[3] * xb[3];
                    const f32x4 w0 = *(const f32x4*)(nw + col) * (*(const f32x4*)(mb + 4 * D + col) + 1.0f), w1 = *(const f32x4*)(nw + col + 4) * (*(const f32x4*)(mb + 4 * D + col + 4) + 1.0f);
                    *(u32x4*)(an + (size_t)row * D + col) = pack8(xa * w0, xb * w1); }
                ss += __shfl_xor(ss, 16); ss += __shfl_xor(ss, 32);
                if (fq == 0) atomicAdd(rowss + row, ss); }
    }
};
struct Up {
    static constexpr bool PERM = true, AFTER_DRAIN = false;
    bf16_t* u_; int ldu; const float* rowss; const float* shw; int coff;
    __device__ __forceinline__ void operator()(const f32x4 (&acc)[2][2][4][2], const Unit& u, int wr, int wc, int fr, int fq) const {
        const int row0 = u.pm * 256 + wr * 64 + fr, col0 = u.pn * 256 + wc * 32 + 8 * fq;
        const float* sb = shw + ((u.pm * 256) >> 13) * (2 * DFF) + coff + col0;
        f32x4 sh[2][2];
#pragma unroll
        for (int bj = 0; bj < 2; ++bj) { sh[bj][0] = *(const f32x4*)(sb + bj * 128); sh[bj][1] = *(const f32x4*)(sb + bj * 128 + 4); }
#pragma unroll
        for (int ai = 0; ai < 2; ++ai)
#pragma unroll
            for (int m = 0; m < 4; ++m) { const int row = row0 + ai * 128 + m * 16; const float rs = rsqrtf(rowss[row] * (1.0f / D) + EPS);
#pragma unroll
                for (int bj = 0; bj < 2; ++bj) *(u32x4*)(u_ + (size_t)row * ldu + col0 + bj * 128) = pack8(acc[ai][bj][m][0] * rs + sh[bj][0], acc[ai][bj][m][1] * rs + sh[bj][1]); }
    }
};
}

struct MapInS { __device__ int col(int n) const { return n < 3072 ? n : (n < 5120 ? n + 32 : (n < 5152 ? 3072 + (n - 5120) : (n < NST ? n : -1))); }
                __device__ float scale(int n) const { return (n >= 3072 && n < 3584) ? QSCALE : 1.0f; } };
struct MapOff { int off; __device__ int col(int n) const { return off + n; } __device__ float scale(int) const { return 1.0f; } };
struct MapUp { __device__ int col(int n) const { if (n < UPA_N) return n < UPA_C ? n : DFF + (n - UPA_C); const int j = n - UPA_N; return j < UPB_C ? UPA_C + j : DFF + UPA_C + (j - UPB_C); }
               __device__ float scale(int) const { return 1.0f; } };
template <class Map>
__device__ __forceinline__ void wt_item(const float* W, int K, int ldw, int nrows, bf16_t* WT, const Map map, LAS float* scr, int item, int lane) {
    const int nblk = nrows / 64, kb = item / nblk, nb = item % nblk, k0 = 64 * kb, n0 = 64 * nb;
    const int sc = map.col(n0 + lane); const float s = map.scale(n0 + lane);
#pragma unroll
    for (int kk = 0; kk < 64; ++kk) scr[kk * 65 + lane] = sc >= 0 ? W[(size_t)(k0 + kk) * ldw + sc] * s : 0.f;
    asm volatile("s_waitcnt lgkmcnt(0)" ::: "memory");
    const int c = lane & 7;
#pragma unroll
    for (int j = 0; j < 8; ++j) { const int n = (lane >> 3) + 8 * j; const LAS float* q = scr + (8 * c) * 65 + n;
        u32x4 o; o.x = pk2(q[0 * 65], q[1 * 65]); o.y = pk2(q[2 * 65], q[3 * 65]); o.z = pk2(q[4 * 65], q[5 * 65]); o.w = pk2(q[6 * 65], q[7 * 65]);
        *(u32x4*)(WT + (size_t)(n0 + n) * K + k0 + 8 * c) = o; }
    asm volatile("s_waitcnt lgkmcnt(0)" ::: "memory");
}
template <class Map>
__device__ __forceinline__ void wt_convert(const float* W, int K, int ldw, int nrows, bf16_t* WT, const Map map, LAS unsigned char* lds, int gw, int ngw) {
    LAS float* scr = (LAS float*)(lds + (threadIdx.x >> 6) * 16896);
    const int items = (K / 64) * (nrows / 64), lane = threadIdx.x & 63;
    for (int it = gw; it < items; it += ngw) wt_item(W, K, ldw, nrows, WT, map, scr, it, lane);
}

__device__ __forceinline__ void phase_mod(const P& p, int bid, int nblk, float* smem) {
    float* mod = (float*)(p.ws + WS_MOD);
    float* s = smem;
    float* red = smem + 5 * 1024;
    const int tid = threadIdx.x;
    for (int i = tid; i < 5 * 1024; i += NTHREADS) { const int v = i >> 10, k = i & 1023; const float cv = v < 4 ? p.c[v * 1024 + k] : p.c_ctx[k]; s[i] = siluf_(cv); }
    __syncthreads();
    const int cl = tid & 31, sl = tid >> 5;
    for (int item = bid; item < (NMOD * D) / 32; item += nblk) {
        const int col = item * 32 + cl;
        float a[5] = {0.f, 0.f, 0.f, 0.f, 0.f};
#pragma unroll 8
        for (int k = sl * 64; k < (sl + 1) * 64; ++k) {
            const float w = p.w_ada[(size_t)k * (NMOD * D) + col];
#pragma unroll
            for (int v = 0; v < 5; ++v) a[v] += s[v * 1024 + k] * w;
        }
#pragma unroll
        for (int v = 0; v < 5; ++v) red[(sl * 5 + v) * 32 + cl] = a[v];
        __syncthreads();
        if (tid < 160) { const int v = tid >> 5, c2 = tid & 31; float t = 0.f;
#pragma unroll
            for (int q = 0; q < 16; ++q) t += red[(q * 5 + v) * 32 + c2];
            mod[v * (NMOD * D) + item * 32 + c2] = t + p.b_ada[item * 32 + c2]; }
        __syncthreads();
    }
}

__device__ __forceinline__ void phase_shw(const P& p, int bid, int nblk, float* smem) {
    const float* mod = (const float*)(p.ws + WS_MOD); float* shw = (float*)(p.ws + WS_SHW);
    float* sv = smem;
    float* red = smem + 4 * 1024;
    const int tid = threadIdx.x;
    for (int i = tid; i < 4 * 1024; i += NTHREADS) sv[i] = mod[(i >> 10) * (NMOD * D) + 3 * D + (i & 1023)];
    __syncthreads();
    const int cl = tid & 31, sl = tid >> 5; const MapUp mp{};
    for (int item = bid; item < (2 * DFF) / 32; item += nblk) {
        const int sc = mp.col(item * 32 + cl);
        float a[4] = {0.f, 0.f, 0.f, 0.f};
#pragma unroll 32
        for (int k = sl * 64; k < (sl + 1) * 64; ++k) { const float w = p.w_up[(size_t)k * (2 * DFF) + sc];
#pragma unroll
            for (int v = 0; v < 4; ++v) a[v] += sv[v * 1024 + k] * w; }
#pragma unroll
        for (int v = 0; v < 4; ++v) red[(sl * 4 + v) * 32 + cl] = a[v];
        __syncthreads();
        if (tid < 128) { const int v = tid >> 5, c2 = tid & 31; float t = 0.f;
#pragma unroll
            for (int q = 0; q < 16; ++q) t += red[(q * 4 + v) * 32 + c2];
            shw[v * (2 * DFF) + item * 32 + c2] = t; }
        __syncthreads();
    }
}

__device__ __forceinline__ void phase_norm(const P& p, int which, int r0, int r1, bf16_t* dst, int bid, int nblk) {
    const float* mod = (const float*)(p.ws + WS_MOD);
    const int lane = threadIdx.x & 63, wv = threadIdx.x >> 6, nwv = blockDim.x >> 6, gwv = bid * nwv + wv, ngw = nblk * nwv;
    const float* w = which == 1 ? p.norm1_w : p.norm2_w;
    f32x4 fa[4], fb[4]; int cur = -1;
    for (int rb = r0 + 4 * gwv; rb < r1; rb += 4 * ngw) {
        f32x4 v[4][4]; float ss[4] = {0.f, 0.f, 0.f, 0.f};
#pragma unroll
        for (int q = 0; q < 4; ++q) { const int r = (rb + q < r1) ? rb + q : rb;
            const float* src = which == 1 ? (r < MX ? p.x + (size_t)r * D : p.ctx + (size_t)(r - MX) * D) : p.out + (size_t)r * D;
#pragma unroll
            for (int j = 0; j < 4; ++j) v[q][j] = *(const f32x4*)(src + j * 256 + lane * 4); }
#pragma unroll
        for (int q = 0; q < 4; ++q) {
#pragma unroll
            for (int j = 0; j < 4; ++j) ss[q] += v[q][j].x * v[q][j].x + v[q][j].y * v[q][j].y + v[q][j].z * v[q][j].z + v[q][j].w * v[q][j].w;
            ss[q] = wave_sum(ss[q]); }
#pragma unroll
        for (int q = 0; q < 4; ++q) { const int r = rb + q; if (r >= r1) break;
            const int mv = row_modv(r);
            if (mv != cur) { cur = mv;
                const float* sc = mod + mv * (NMOD * D) + (which == 1 ? 1 : 4) * D;
                const float* sh = mod + mv * (NMOD * D) + (which == 1 ? 0 : 3) * D;
#pragma unroll
                for (int j = 0; j < 4; ++j) { const int c0 = j * 256 + lane * 4; fa[j] = *(const f32x4*)(w + c0) * (*(const f32x4*)(sc + c0) + 1.0f); fb[j] = *(const f32x4*)(sh + c0); } }
            const float rs = rsqrtf(ss[q] * (1.0f / D) + EPS);
#pragma unroll
            for (int j = 0; j < 4; ++j) { const int c0 = j * 256 + lane * 4;
                const f32x4 y = v[q][j] * rs * fa[j] + fb[j];
                uint2 o; o.x = pk2(y.x, y.y); o.y = pk2(y.z, y.w);
                __builtin_nontemporal_store((u32x2){o.x, o.y}, (u32x2*)(dst + (size_t)r * D + c0)); } }
    }
}

typedef float f32x2_t __attribute__((ext_vector_type(2)));
__device__ __forceinline__ f32x2_t bf2_to_f32(unsigned v) { return (f32x2_t){__uint_as_float(v << 16), __uint_as_float(v & 0xffff0000u)}; }
template <int XB>
__device__ __forceinline__ void phase_convact(const P& p, int c0, int nc, int bid, int nblk, LAS unsigned char* lds) {
    const bf16_t* U = (const bf16_t*)(p.ws + WS_U); bf16_t* ACT = (bf16_t*)(p.ws + WS_ACT);
    const int ldu = 2 * nc, ncg = nc >> 1, nthr = nblk * NTHREADS;
    LAS float* wl = (LAS float*)lds;
    for (int i = threadIdx.x; i < 9 * ldu; i += NTHREADS) { const int tap = i / ldu, cc = i - tap * ldu; wl[i] = p.ffn_conv[tap * (2 * DFF) + (cc < nc ? c0 + cc : DFF + c0 + (cc - nc))]; }
    __syncthreads();
    constexpr int NXB = 64 / XB, WC = XB + 2;
    int S = nthr / (4 * NXB * ncg); S = S < 1 ? 1 : (S > 64 ? 64 : S);
    const int LY = (128 + S - 1) / S, items = 4 * NXB * ncg * S;
    const int vbid = (nblk & 7) ? bid : (bid & 7) * (nblk >> 3) + (bid >> 3);
    const int ncw = ncg >> 6;
    for (int idx = vbid * NTHREADS + (int)threadIdx.x; idx < items; idx += nthr) {
        const int wi = __builtin_amdgcn_readfirstlane(idx >> 6);
        const int cg = (wi % ncw) * 64 + (int)(threadIdx.x & 63); int r = wi / ncw; const int xb = r % NXB; r /= NXB; const int ys = r % S, b = r / S, c = cg * 2;
        const int y0 = ys * LY, y1 = (y0 + LY < 128) ? y0 + LY : 128;
        if (y0 >= 128) continue;
        const LAS float* wq = wl + c;
        const int x0 = xb * XB;
        const bf16_t* ub = U + (size_t)(b * T) * ldu + c;
        bf16_t* ob = ACT + (size_t)(b * T) * DFF + c0 + c;
        const bool zl = xb == 0, zr = xb == NXB - 1;
        unsigned w0[WC][2], w1[WC][2], w2[WC][2], w3[WC][2];
#define CA_LOAD(W_, y_) do { const int yy_ = (y_); const bool ok_ = yy_ >= 0 && yy_ < 128; const int yc_ = yy_ < 0 ? 0 : (yy_ > 127 ? 127 : yy_); \
            _Pragma("unroll") for (int j = 0; j < WC; ++j) { const int xi_ = x0 - 1 + j, xc_ = xi_ < 0 ? 0 : (xi_ > 63 ? 63 : xi_); const bf16_t* q_ = ub + (size_t)(yc_ * 64 + xc_) * ldu; \
                const bool z_ = !ok_ || (j == 0 && zl) || (j == WC - 1 && zr); const unsigned g_ = *(const unsigned*)q_, v_ = *(const unsigned*)(q_ + nc); \
                (W_)[j][0] = z_ ? 0u : g_; (W_)[j][1] = z_ ? 0u : v_; } } while (0)
#define CA_ROW(y_, A_, B_, C_) do { f32x2_t G_[XB], V_[XB]; _Pragma("unroll") for (int j = 0; j < XB; ++j) { G_[j] = (f32x2_t){0.f, 0.f}; V_[j] = (f32x2_t){0.f, 0.f}; } \
            f32x2_t wg_[3][3], wv_[3][3]; \
            _Pragma("unroll") for (int dy = 0; dy < 3; ++dy) _Pragma("unroll") for (int dx = 0; dx < 3; ++dx) { wg_[dy][dx] = *(const LAS f32x2_t*)(wq + (dy * 3 + dx) * ldu); wv_[dy][dx] = *(const LAS f32x2_t*)(wq + (dy * 3 + dx) * ldu + nc); } \
            _Pragma("unroll") for (int col = 0; col < WC; ++col) { \
                const f32x2_t ua_ = bf2_to_f32((A_)[col][0]), ub_ = bf2_to_f32((B_)[col][0]), uc_ = bf2_to_f32((C_)[col][0]); \
                const f32x2_t va_ = bf2_to_f32((A_)[col][1]), vb_ = bf2_to_f32((B_)[col][1]), vc_ = bf2_to_f32((C_)[col][1]); \
                _Pragma("unroll") for (int dx = 0; dx < 3; ++dx) { const int j = col - dx; if (j >= 0 && j < XB) { \
                    G_[j] = G_[j] + wg_[0][dx] * ua_ + wg_[1][dx] * ub_ + wg_[2][dx] * uc_; V_[j] = V_[j] + wv_[0][dx] * va_ + wv_[1][dx] * vb_ + wv_[2][dx] * vc_; } } } \
            _Pragma("unroll") for (int j = 0; j < XB; ++j) __builtin_nontemporal_store(pk2(silu_fast(G_[j].x) * V_[j].x, silu_fast(G_[j].y) * V_[j].y), (unsigned*)(ob + (size_t)((y_) * 64 + x0 + j) * DFF)); } while (0)
        CA_LOAD(w0, y0 - 1); CA_LOAD(w1, y0); CA_LOAD(w2, y0 + 1);
#pragma unroll 1
        for (int y = y0; y < y1; y += 4) {
            CA_LOAD(w3, y + 2); CA_ROW(y, w0, w1, w2); if (y + 1 >= y1) break;
            CA_LOAD(w0, y + 3); CA_ROW(y + 1, w1, w2, w3); if (y + 2 >= y1) break;
            CA_LOAD(w1, y + 4); CA_ROW(y + 2, w2, w3, w0); if (y + 3 >= y1) break;
            CA_LOAD(w2, y + 5); CA_ROW(y + 3, w3, w0, w1);
        }
#undef CA_LOAD
#undef CA_ROW
    }
}

__device__ __forceinline__ void phase_final(const P& p, int bid, int nblk) {
    const int lane = threadIdx.x & 63, wv = threadIdx.x >> 6, nwv = blockDim.x >> 6, gwv = bid * nwv + wv, ngw = nblk * nwv;
    f32x4 fw[4];
#pragma unroll
    for (int j = 0; j < 4; ++j) fw[j] = *(const f32x4*)(p.norm_out_w + j * 256 + lane * 4);
    for (int rb = 4 * gwv; rb < MX; rb += 4 * ngw) {
        f32x4 v[4][4]; float ss[4] = {0.f, 0.f, 0.f, 0.f};
#pragma unroll
        for (int q = 0; q < 4; ++q)
#pragma unroll
            for (int j = 0; j < 4; ++j) v[q][j] = *(const f32x4*)(p.out + (size_t)(rb + q) * D + j * 256 + lane * 4);
#pragma unroll
        for (int q = 0; q < 4; ++q) {
#pragma unroll
            for (int j = 0; j < 4; ++j) ss[q] += v[q][j].x * v[q][j].x + v[q][j].y * v[q][j].y + v[q][j].z * v[q][j].z + v[q][j].w * v[q][j].w;
            ss[q] = wave_sum(ss[q]); }
#pragma unroll
        for (int q = 0; q < 4; ++q) { const float rs = rsqrtf(ss[q] * (1.0f / D) + EPS);
#pragma unroll
            for (int j = 0; j < 4; ++j) __builtin_nontemporal_store(v[q][j] * rs * fw[j], (f32x4*)(p.out + (size_t)(rb + q) * D + j * 256 + lane * 4)); }
    }
}

typedef short bf16x8 __attribute__((ext_vector_type(8)));
typedef short s16x4 __attribute__((ext_vector_type(4)));
#define MFMA16(a, b, c) __builtin_amdgcn_mfma_f32_16x16x32_bf16((a), (b), (c), 0, 0, 0)
__device__ __forceinline__ s16x4 lds_tr4(const LAS unsigned char* p) { return __builtin_bit_cast(s16x4, __builtin_amdgcn_ds_read_tr16_b64_v4i16((LAS s16x4*)p)); }
__device__ __forceinline__ bf16x8 cat8(s16x4 lo, s16x4 hi) { return (bf16x8){lo[0], lo[1], lo[2], lo[3], hi[0], hi[1], hi[2], hi[3]}; }
__device__ __forceinline__ u32x2 pack4(f32x4 v) { u32x2 o; o.x = pg8::cvt_pk_bf16(v[0], v[1]); o.y = pg8::cvt_pk_bf16(v[2], v[3]); return o; }
__device__ __forceinline__ u32x4 mk4(unsigned a, unsigned b, unsigned c, unsigned d) { return (u32x4){a, b, c, d}; }
__device__ __forceinline__ uint2 mk2h(unsigned a, unsigned b) { return make_uint2(a, b); }
__device__ __forceinline__ void lds_put64(LAS void* p, unsigned x, unsigned y) { const u32x2 v = {x, y}; asm volatile("ds_write_b64 %0, %1" :: "v"((unsigned)(size_t)p), "v"(v) : "memory"); }
#define LDS_PUT64(p_, off_, x_, y_) do { const u32x2 v2_ = {(x_), (y_)}; asm volatile("ds_write_b64 %0, %1 offset:%2" :: "v"((unsigned)(size_t)(p_)), "v"(v2_), "i"(off_) : "memory"); } while (0)
constexpr int NSTEP = 132;
__device__ __forceinline__ int chain_chunk(int b, int dir, int s) { if (s < 4) return 512 + b * 4 + (dir ? 3 - s : s); const int c = s - 4; return b * 128 + (dir ? 127 - c : c); }
__device__ __forceinline__ int chunk_row(int g, int dir, int l) { return g * 64 + (dir ? 63 - l : l); }
__device__ __forceinline__ float wave_incl_sum(float v, int lane) {
#pragma unroll
    for (int o = 1; o < 64; o <<= 1) { const float t = __shfl_up(v, o); if (lane >= o) v += t; }
    return v;
}
__device__ __forceinline__ float wave_incl_max(float v, int lane) {
#pragma unroll
    for (int o = 1; o < 64; o <<= 1) { const float t = __shfl_up(v, o); if (lane >= o) v = fmaxf(v, t); }
    return v;
}
__device__ __forceinline__ float wave_max(float v) {
#pragma unroll
    for (int o = 1; o < 64; o <<= 1) v = fmaxf(v, __shfl_xor(v, o));
    return v;
}

__device__ __forceinline__ void ml_chain_scalars(const P& p, int c, LAS float* cb) {
    const float* gates = (const float*)(p.ws + WS_GATES); float* MLS = (float*)(p.ws + WS_MLS);
    const int tid = threadIdx.x, lane = tid & 63, wid = tid >> 6;
    const int dir = c & 1, bh = c >> 1, b = bh >> 2, h = bh & 3;
    const float ib = p.ml_igate_b[dir * 4 + h], fb = p.ml_fgate_b[dir * 4 + h];
    LAS float* bl_a = cb; LAS float* tm_a = cb + 136; LAS float* m_a = cb + 272;
    constexpr int NI = (NSTEP + NWAVES - 1) / NWAVES;
    float igr[NI], fgr[NI];
#pragma unroll
    for (int i = 0; i < NI; ++i) { const int s = wid + NWAVES * i, sc = s < NSTEP ? s : NSTEP - 1; const int g = chain_chunk(b, dir, sc), row = chunk_row(g, dir, lane);
        igr[i] = gates[(size_t)row * 64 + 32 + dir * 4 + h]; fgr[i] = gates[(size_t)row * 64 + 40 + dir * 4 + h]; }
#pragma unroll
    for (int i = 0; i < NI; ++i) { const int s = wid + NWAVES * i;
        const float ig = softcapf_(igr[i] + ib);
        const float lf = -softplusf_(-softcapf_(fgr[i] + fb));
        igr[i] = ig; fgr[i] = lf;
        const float bc = wave_incl_sum(lf, lane), blast = __shfl(bc, 63);
        const float tmax = wave_max(blast + (ig - bc));
        if (lane == 0 && s < NSTEP) { bl_a[s] = blast; tm_a[s] = tmax; }
    }
    __syncthreads();
    if (tid == 0) { float m = 0.f; for (int s = 0; s < NSTEP; ++s) { m_a[s] = m; m = fmaxf(bl_a[s] + m, tm_a[s]); } }
    __syncthreads();
#pragma unroll
    for (int i = 0; i < NI; ++i) { const int s = wid + NWAVES * i;
        const float ig = igr[i], lf = fgr[i];
        const float bc = wave_incl_sum(lf, lane), blast = __shfl(bc, 63);
        const float cs = ig - bc, tail = blast + cs;
        if (s < NSTEP) {
        const float m = m_a[s], mnew = fmaxf(blast + m, tm_a[s]);
        const float wt = __expf(tail - mnew), dec = __expf(blast + m - mnew);
        const float pm = wave_incl_max(cs, lane);
        const float mt = fmaxf(bc + m, bc + pm);
        float* o = MLS + ((size_t)c * NSTEP + s) * 384;
        o[lane] = bc - mt; o[64 + lane] = cs; o[128 + lane] = __expf(bc + m - mt); o[192 + lane] = __expf(-mt); o[256 + lane] = wt; o[320 + lane] = dec; }
    }
    __syncthreads();
}

constexpr int PR_CW = 0, PR_QN = 4608, PR_KN = 22016, PR_KK = 39424, PR_QK = 56064, PR_GS = 72704, PR_A = 73728, PR_BT = 139264, PR_END = 141312;
__device__ __forceinline__ void bf8_to_f32(const u32x4 v, float (&o)[8]) {
    o[0] = __uint_as_float(v.x << 16); o[1] = __uint_as_float(v.x & 0xffff0000u); o[2] = __uint_as_float(v.y << 16); o[3] = __uint_as_float(v.y & 0xffff0000u);
    o[4] = __uint_as_float(v.z << 16); o[5] = __uint_as_float(v.z & 0xffff0000u); o[6] = __uint_as_float(v.w << 16); o[7] = __uint_as_float(v.w & 0xffff0000u);
}
__device__ __forceinline__ void phase_prep2(const P& p, int bid, int nblk, LAS unsigned char* lds) {
    bf16_t* qkv = (bf16_t*)(p.ws + WS_QKV); const bf16_t* halo = (const bf16_t*)(p.ws + WS_HALO); const float* gates = (const float*)(p.ws + WS_GATES);
    bf16_t* TB = (bf16_t*)(p.ws + WS_TB); bf16_t* ATT = (bf16_t*)(p.ws + WS_ATTN); float* GSC = (float*)(p.ws + WS_GSC);
    LAS float* cw = (LAS float*)(lds + PR_CW);
    LAS bf16_t* qn = (LAS bf16_t*)(lds + PR_QN); LAS bf16_t* kn = (LAS bf16_t*)(lds + PR_KN);
    LAS float* kk = (LAS float*)(lds + PR_KK); LAS float* qk = (LAS float*)(lds + PR_QK); LAS float* gs = (LAS float*)(lds + PR_GS);
    LAS bf16_t* Am0 = (LAS bf16_t*)(lds + PR_A);
    const int tid = threadIdx.x, lane = tid & 63, wid = tid >> 6, fr = lane & 15, fq = lane >> 4;
    if (nblk >= 32) { if (bid >= nblk - 32) ml_chain_scalars(p, bid - (nblk - 32), (LAS float*)(lds + PR_END)); }
    else { for (int c = bid; c < 32; c += nblk) ml_chain_scalars(p, c, (LAS float*)(lds + PR_END)); }
    const int NCH = MT / 64;
    int hcur = -1;
    const int r = tid >> 3, c16 = (tid & 7) * 16;
    u32x4 xr[3][3][2];
#define PREP_LOAD(item_) do { const int g_ = (item_) >> 3, h_ = (item_) & 7; bool first_, last_; \
        if (g_ < MX / 64) { first_ = (g_ & 127) == 0; last_ = (g_ & 127) == 127; } else { first_ = ((g_ - MX / 64) & 3) == 0; last_ = ((g_ - MX / 64) & 3) == 3; } \
        _Pragma("unroll") for (int pt_ = 0; pt_ < 3; ++pt_) { const int col_ = pt_ * 1024 + h_ * 128 + c16; const bf16_t* rowp_ = qkv + ((size_t)(pt_ * 8 + h_) * MT + g_ * 64 + r) * 128 + c16; \
            { const bf16_t* pp_ = r > 0 ? rowp_ - 128 : halo + ((size_t)(g_ - 1) * 2 + 1) * 3072 + col_; const bool z_ = (r == 0) && first_; \
              xr[pt_][0][0] = z_ ? (u32x4){0u, 0u, 0u, 0u} : *(const u32x4*)pp_; xr[pt_][0][1] = z_ ? (u32x4){0u, 0u, 0u, 0u} : *(const u32x4*)(pp_ + 8); } \
            xr[pt_][1][0] = *(const u32x4*)rowp_; xr[pt_][1][1] = *(const u32x4*)(rowp_ + 8); \
            { const bf16_t* pn_ = r < 63 ? rowp_ + 128 : halo + ((size_t)(g_ + 1) * 2 + 0) * 3072 + col_; const bool z_ = (r == 63) && last_; \
              xr[pt_][2][0] = z_ ? (u32x4){0u, 0u, 0u, 0u} : *(const u32x4*)pn_; xr[pt_][2][1] = z_ ? (u32x4){0u, 0u, 0u, 0u} : *(const u32x4*)(pn_ + 8); } } } while (0)
    const bool bal = (nblk == 256);
    const int reg_cnt = bal ? (bid >= 224 ? 12 : (bid < 128 ? 17 : 16)) : (bid < NCH * 8 ? (NCH * 8 - bid + nblk - 1) / nblk : 0);
    const int cnt = reg_cnt + ((bal && (bid < 32 || (bid >= 128 && bid < 224))) ? 1 : 0);
    const int xa = bid >= 128 ? (bid - 128) >> 3 : 12 + (bid >> 3);
    const int xitem = 224 + (bid & 7) + 8 * (xa >> 2) + 256 * (12 + (xa & 3));
#define PREP_ITEM(q_) ((q_) < reg_cnt ? bid + (q_) * nblk : xitem)
    for (int q0 = 0; q0 < cnt; q0 += 4) {
      int myitem = -1;
#pragma unroll 1
      for (int kb = 0; kb < 4; ++kb) {
        const int q = q0 + kb; if (q >= cnt) break;
        const int item = PREP_ITEM(q);
        const int g = item >> 3, h = item & 7;
        PREP_LOAD(item);
        float ga_pre = 0.f, gb_pre = 0.f, alog_pre = 0.f, dtb_pre = 0.f;
        if (wid < 2) { const int row_ = chunk_row(g, wid, lane); ga_pre = gates[(size_t)row_ * 64 + wid * 8 + h]; gb_pre = gates[(size_t)row_ * 64 + 16 + wid * 8 + h]; alog_pre = p.gdn_a_log[wid * 8 + h]; dtb_pre = p.gdn_dt_bias[wid * 8 + h]; }
        if (h != hcur) { __syncthreads(); for (int i = tid; i < 9 * 128; i += NTHREADS) { const int pt = i / 384, tap = (i / 128) % 3, cc = i & 127; cw[i] = p.gdn_conv[tap * 3072 + pt * 1024 + h * 128 + cc]; } hcur = h; }
        asm volatile("s_waitcnt vmcnt(0)" ::: "memory");
        __syncthreads();
#pragma unroll
        for (int part = 0; part < 3; ++part) {
            const int col = part * 1024 + h * 128 + c16;
            bf16_t* rowp = qkv + ((size_t)(part * 8 + h) * MT + g * 64 + r) * 128 + c16;
            float y[16]; float ss = 0.f;
#pragma unroll
            for (int hf = 0; hf < 2; ++hf) { float a0[8], a1[8], a2[8]; bf8_to_f32(xr[part][0][hf], a0); bf8_to_f32(xr[part][1][hf], a1); bf8_to_f32(xr[part][2][hf], a2);
#pragma unroll
                for (int i = 0; i < 8; ++i) { const int cc = c16 + hf * 8 + i; const LAS float* w = cw + part * 384 + cc;
                    const float v = silu_fast(w[0] * a0[i] + w[128] * a1[i] + w[256] * a2[i]); y[hf * 8 + i] = v; ss += v * v; } }
            float rs = 1.0f;
            if (part < 2) { ss += __shfl_xor(ss, 1); ss += __shfl_xor(ss, 2); ss += __shfl_xor(ss, 4); rs = rsqrtf(ss + EPS) * (part == 0 ? QSCALE : 1.0f); }
            u32x4 o0, o1;
            o0.x = pk2(y[0] * rs, y[1] * rs); o0.y = pk2(y[2] * rs, y[3] * rs); o0.z = pk2(y[4] * rs, y[5] * rs); o0.w = pk2(y[6] * rs, y[7] * rs);
            o1.x = pk2(y[8] * rs, y[9] * rs); o1.y = pk2(y[10] * rs, y[11] * rs); o1.z = pk2(y[12] * rs, y[13] * rs); o1.w = pk2(y[14] * rs, y[15] * rs);
            *(u32x4*)rowp = o0; *(u32x4*)(rowp + 8) = o1;
            if (part == 0) { *(LAS u32x4*)(qn + r * 136 + c16) = o0; *(LAS u32x4*)(qn + r * 136 + c16 + 8) = o1; }
            if (part == 1) { *(LAS u32x4*)(kn + r * 136 + c16) = o0; *(LAS u32x4*)(kn + r * 136 + c16 + 8) = o1; }
        }
        { const int ni = PREP_ITEM(q + 1);
          if (kb < 3 && q + 1 < cnt && tid < 384) { const int g2 = ni >> 3, h2 = ni & 7, pt2 = tid >> 7, rr2 = (tid & 127) >> 1, hf2 = tid & 1;
              const unsigned off2 = (unsigned)(((pt2 * 8 + h2) * MT + g2 * 64 + rr2) * 128 + hf2 * 64); const bf16_t* gp = qkv + off2;
              __builtin_amdgcn_global_load_lds((const unsigned*)gp, (LAS unsigned*)(lds + 152064 + wid * 256), 4, 0, 0); } }
        if (wid < 2) { const int dir = wid;
            const float alog = -__expf(alog_pre); const float xg = ga_pre + dtb_pre;
            const float gl = alog * (xg > 20.f ? xg : __logf(1.0f + __expf(xg)));
            const float gc = wave_incl_sum(gl, lane), glast = __shfl(gc, 63);
            gs[dir * 64 + lane] = gc; gs[128 + dir * 64 + lane] = sigmoidf_(gb_pre);
            float* o = GSC + ((size_t)item * 2 + dir) * 128; o[lane] = __expf(gc); o[64 + lane] = __expf(glast - gc); }
        __syncthreads();
#pragma unroll
        for (int i = 0; i < 2; ++i) { const int t = wid * 2 + i, mt = t >> 2, nt = t & 3; f32x4 a1 = {0.f, 0.f, 0.f, 0.f}, a2 = {0.f, 0.f, 0.f, 0.f};
#pragma unroll
            for (int q4 = 0; q4 < 4; ++q4) { const bf16x8 bk = *(const LAS bf16x8*)(kn + (16 * nt + fr) * 136 + 32 * q4 + 8 * fq);
                const bf16x8 ak = *(const LAS bf16x8*)(kn + (16 * mt + fr) * 136 + 32 * q4 + 8 * fq), aq = *(const LAS bf16x8*)(qn + (16 * mt + fr) * 136 + 32 * q4 + 8 * fq);
                a1 = MFMA16(ak, bk, a1); a2 = MFMA16(aq, bk, a2); }
#pragma unroll
            for (int q4 = 0; q4 < 4; ++q4) { kk[(16 * mt + 4 * fq + q4) * 65 + 16 * nt + fr] = a1[q4]; qk[(16 * mt + 4 * fq + q4) * 65 + 16 * nt + fr] = a2[q4]; } }
        __syncthreads();
        { const int dir = tid >> 8, l = (tid >> 2) & 63, s0 = (tid & 3) * 16; const int lt = dir ? 63 - l : l;
            const float gl = gs[dir * 64 + l], bl = gs[128 + dir * 64 + l]; float av[16], aa[16];
#pragma unroll
            for (int i = 0; i < 16; ++i) { const int s = s0 + i, st = dir ? 63 - s : s;
                const float dc = s <= l ? __expf(gl - gs[dir * 64 + s]) : 0.f;
                aa[i] = s < l ? bl * kk[lt * 65 + st] * dc : 0.f; av[i] = qk[lt * 65 + st] * dc; }
            { u32x4 a0_, a1_; a0_.x = pk2(aa[0], aa[1]); a0_.y = pk2(aa[2], aa[3]); a0_.z = pk2(aa[4], aa[5]); a0_.w = pk2(aa[6], aa[7]); a1_.x = pk2(aa[8], aa[9]); a1_.y = pk2(aa[10], aa[11]); a1_.z = pk2(aa[12], aa[13]); a1_.w = pk2(aa[14], aa[15]);
              LAS bf16_t* ad_ = Am0 + (kb * 2 + dir) * 4096 + l * 64 + s0; *(LAS u32x4*)ad_ = a0_; *(LAS u32x4*)(ad_ + 8) = a1_; }
            u32x4 o0, o1;
            o0.x = pk2(av[0], av[1]); o0.y = pk2(av[2], av[3]); o0.z = pk2(av[4], av[5]); o0.w = pk2(av[6], av[7]);
            o1.x = pk2(av[8], av[9]); o1.y = pk2(av[10], av[11]); o1.z = pk2(av[12], av[13]); o1.w = pk2(av[14], av[15]);
            bf16_t* ap = ATT + ((size_t)item * 2 + dir) * 4096 + l * 64 + s0; *(u32x4*)ap = o0; *(u32x4*)(ap + 8) = o1; }
        __syncthreads();
        if (wid < 2) ((LAS float*)(lds + PR_BT))[(kb * 2 + wid) * 64 + lane] = gs[128 + wid * 64 + lane];
        if ((wid >> 1) == kb) myitem = item;
      }
      __syncthreads();
      if (myitem >= 0) {
          int tl_ = tid; asm volatile("" : "+v"(tl_));
          const int lane = tl_ & 63, wid = tl_ >> 6, fr = lane & 15, fq = lane >> 4;
          const int dir = wid & 1; LAS bf16_t* A = Am0 + ((wid >> 1) * 2 + dir) * 4096;
          LAS bf16_t* Tt = (LAS bf16_t*)(lds + PR_QN) + wid * 2048; LAS bf16_t* Tr = Tt + 1024;
          const LAS float* btp = (const LAS float*)(lds + PR_BT) + ((wid >> 1) * 2 + dir) * 64;
          const int lb = lane >> 4, lr = lane & 15;
          float t[16];
#pragma unroll
          for (int rr = 0; rr < 16; ++rr) { const LAS bf16_t* ar = A + (16 * lb + rr) * 64 + 16 * lb; float av[16];
              { float h0[8], h1[8]; bf8_to_f32(*(const LAS u32x4*)ar, h0); bf8_to_f32(*(const LAS u32x4*)(ar + 8), h1);
#pragma unroll
                for (int i = 0; i < 8; ++i) { av[i] = h0[i]; av[8 + i] = h1[i]; } }
              float a0 = (rr == lr) ? 1.f : 0.f, a1 = 0.f;
#pragma unroll
              for (int sx = 0; sx < rr; ++sx) { if (sx & 1) a1 -= av[sx] * t[sx]; else a0 -= av[sx] * t[sx]; }
              t[rr] = a0 + a1; }
          { u32x4 p0, p1; p0.x = pk2(t[0], t[1]); p0.y = pk2(t[2], t[3]); p0.z = pk2(t[4], t[5]); p0.w = pk2(t[6], t[7]); p1.x = pk2(t[8], t[9]); p1.y = pk2(t[10], t[11]); p1.z = pk2(t[12], t[13]); p1.w = pk2(t[14], t[15]);
            *(LAS u32x4*)(Tt + (16 * lb + lr) * 16) = p0; *(LAS u32x4*)(Tt + (16 * lb + lr) * 16 + 8) = p1;
#pragma unroll
            for (int rr = 0; rr < 16; ++rr) Tr[(16 * lb + rr) * 16 + lr] = f2bf(t[rr]); }
          asm volatile("s_waitcnt lgkmcnt(0)" ::: "memory");
#define INV_W8(v_) ((bf16x8){(v_)[0], (v_)[1], (v_)[2], (v_)[3], 0, 0, 0, 0})
#define INV_MF(a_, b_, c_) MFMA16(INV_W8(a_), INV_W8(b_), (c_))
#define INV_AOP(i_, k_) (*(const LAS s16x4*)(A + (16 * (i_) + fr) * 64 + 16 * (k_) + 4 * fq))
#define INV_DCOL(j_) (*(const LAS s16x4*)(Tt + (16 * (j_) + fr) * 16 + 4 * fq))
#define INV_DROW(i_) (*(const LAS s16x4*)(Tr + (16 * (i_) + fr) * 16 + 4 * fq))
#define INV_PK(v_) __builtin_bit_cast(s16x4, pack4(v_))
#define INV_FIN(dst_, drow_, s_) do { const f32x4 ns_ = -(s_); const u32x2 hi_ = pack4(ns_); const f32x4 lo_ = ns_ - bf4_to_f32(make_uint2(hi_.x, hi_.y)); \
              (dst_) = INV_MF((drow_), __builtin_bit_cast(s16x4, hi_), z4); (dst_) = INV_MF((drow_), INV_PK(lo_), (dst_)); } while (0)
          { const f32x4 z4 = {0.f, 0.f, 0.f, 0.f};
            const s16x4 a10 = INV_AOP(1, 0), a21 = INV_AOP(2, 1), a32 = INV_AOP(3, 2), a20 = INV_AOP(2, 0), a31 = INV_AOP(3, 1), a30 = INV_AOP(3, 0);
            const s16x4 c0 = INV_DCOL(0), c1 = INV_DCOL(1), c2 = INV_DCOL(2), r1 = INV_DROW(1), r2 = INV_DROW(2), r3 = INV_DROW(3);
            f32x4 T10, T21, T32, T20, T31, T30, S;
            S = INV_MF(a10, c0, z4); INV_FIN(T10, r1, S);
            S = INV_MF(a21, c1, z4); INV_FIN(T21, r2, S);
            S = INV_MF(a32, c2, z4); INV_FIN(T32, r3, S);
            const s16x4 b10 = INV_PK(T10), b21 = INV_PK(T21);
            S = INV_MF(a20, c0, z4); S = INV_MF(a21, b10, S); INV_FIN(T20, r2, S);
            S = INV_MF(a31, c1, z4); S = INV_MF(a32, b21, S); INV_FIN(T31, r3, S);
            const s16x4 b20 = INV_PK(T20);
            S = INV_MF(a30, c0, z4); S = INV_MF(a31, b10, S); S = INV_MF(a32, b20, S); INV_FIN(T30, r3, S);
            asm volatile("" ::: "memory");
#define INV_PUT(T_, i_, j_) do { const float bt_ = btp[16 * (j_) + fr]; _Pragma("unroll") for (int q4 = 0; q4 < 4; ++q4) A[(16 * (i_) + 4 * fq + q4) * 64 + 16 * (j_) + fr] = f2bf((T_)[q4] * bt_); } while (0)
            INV_PUT(T10, 1, 0); INV_PUT(T21, 2, 1); INV_PUT(T32, 3, 2); INV_PUT(T20, 2, 0); INV_PUT(T31, 3, 1); INV_PUT(T30, 3, 0);
            { const float bt_ = btp[16 * lb + lr];
#pragma unroll
              for (int rr = 0; rr < 16; ++rr) A[(16 * lb + rr) * 64 + 16 * lb + lr] = f2bf(t[rr] * bt_); }
            asm volatile("s_waitcnt lgkmcnt(0)" ::: "memory"); }
#undef INV_MF
#undef INV_W8
#undef INV_AOP
#undef INV_DCOL
#undef INV_DROW
#undef INV_PK
#undef INV_FIN
#undef INV_PUT
          bf16_t* o = TB + ((size_t)myitem * 2 + dir) * 4096;
#pragma unroll
          for (int i8 = 0; i8 < 8; ++i8) { const int row = (lane >> 3) + 8 * i8, c8 = (lane & 7) * 8; *(u32x4*)(o + row * 64 + c8) = *(const LAS u32x4*)(A + row * 64 + c8); } }
      __syncthreads();
    }
#undef PREP_LOAD
#undef PREP_ITEM
}

constexpr int SC_TEAM = 81856;
constexpr int G2_K0 = 0, G2_K1 = 17408, G2_QC = 34816, G2_TB = 52224, G2_AT = 61440, G2_VC = 70656, G2_SC = 79872, G2_END = 80896;
static_assert(G2_END <= SC_TEAM, "gdn2 lds");
constexpr int XSTEP = 68;
__device__ __forceinline__ bf16x8 pack8f(const f32x4 a, const f32x4 b) { const u32x2 x = pack4(a), y = pack4(b); return __builtin_bit_cast(bf16x8, mk4(x.x, x.y, y.x, y.y)); }
__device__ __forceinline__ void gdn_scan2(const P& p, int n, LAS unsigned char* lds) {
    const bf16_t* qkv = (const bf16_t*)(p.ws + WS_QKV); const bf16_t* TB = (const bf16_t*)(p.ws + WS_TB); const bf16_t* ATT = (const bf16_t*)(p.ws + WS_ATTN);
    const float* GSC = (const float*)(p.ws + WS_GSC); bf16_t* O = (bf16_t*)p.out;
    const int tid = threadIdx.x, lane = tid & 63, wid = tid >> 6, tt = tid & 255, fr = lane & 15, fq = lane >> 4;
    const bool loader = wid >= 4;
    const int dir = loader ? 0 : (wid >> 1), tw = wid & 1;
    const int bh = n >> 2, dvq = n & 3, b = bh >> 3, h = bh & 7;
    LAS unsigned char* L = lds + dir * SC_TEAM;
    LAS bf16_t* Qc = (LAS bf16_t*)(L + G2_QC); LAS bf16_t* Tbc = (LAS bf16_t*)(L + G2_TB); LAS bf16_t* Atc = (LAS bf16_t*)(L + G2_AT); LAS bf16_t* Vc = (LAS bf16_t*)(L + G2_VC);
    const int srow = tt >> 2, sq = tt & 3;
#define G2_CLAMP(s_) ((s_) < NSTEP ? (s_) : NSTEP - 1)
#define G2_FX_K(s_) do { _Pragma("unroll") for (int d_ = 0; d_ < 2; ++d_) { const int g_ = chain_chunk(b, d_, (s_)); \
        const bf16_t* rp_ = qkv + ((size_t)h * MT + chunk_row(g_, d_, srow)) * 128 + (size_t)8 * MT * 128 + sq * 32; \
        _Pragma("unroll") for (int i_ = 0; i_ < 4; ++i_) kst[d_][i_] = *(const u32x4*)(rp_ + 8 * i_); \
        scv[d_] = GSC[((size_t)(g_ * 8 + h) * 2 + d_) * 128 + (tt & 127)]; } } while (0)
#define G2_FX_T(s_, tst, ast, ost) do { _Pragma("unroll") for (int d_ = 0; d_ < 2; ++d_) { const int g_ = chain_chunk(b, d_, (s_)); const size_t it_ = ((size_t)(g_ * 8 + h) * 2 + d_); \
        const bf16_t* tp_ = TB + it_ * 4096 + srow * 64 + sq * 16; const bf16_t* ap_ = ATT + it_ * 4096 + srow * 64 + sq * 16; \
        tst[d_][0] = *(const u32x4*)tp_; tst[d_][1] = *(const u32x4*)(tp_ + 8); ast[d_][0] = *(const u32x4*)ap_; ast[d_][1] = *(const u32x4*)(ap_ + 8); \
        const int go_ = g_ < 512 ? g_ : 511; ost[d_] = *(const u32x4*)(O + (size_t)chunk_row(go_, d_, srow) * 1024 + h * 128 + dvq * 32 + sq * 8); } } while (0)
#define G2_FY(s_) do { _Pragma("unroll") for (int d_ = 0; d_ < 2; ++d_) { const int g_ = chain_chunk(b, d_, (s_)); \
        const bf16_t* rp_ = qkv + ((size_t)h * MT + chunk_row(g_, d_, srow)) * 128; \
        _Pragma("unroll") for (int i_ = 0; i_ < 4; ++i_) qst[d_][i_] = *(const u32x4*)(rp_ + sq * 32 + 8 * i_); } } while (0)
#define G2_FV(s_, vst) do { _Pragma("unroll") for (int d_ = 0; d_ < 2; ++d_) { const int g_ = chain_chunk(b, d_, (s_)); \
        vst[d_] = *(const u32x4*)(qkv + ((size_t)h * MT + chunk_row(g_, d_, srow)) * 128 + (size_t)16 * MT * 128 + dvq * 32 + sq * 8); } } while (0)
#define G2_PUT(dst_, i_, v_) do { LDS_PUT64((dst_), 8 * (((i_) < 2) ? 4 * (i_) : 4 * ((i_) - 2) + 1), (v_).x, (v_).y); LDS_PUT64((dst_), 8 * ((((i_) < 2) ? 4 * (i_) : 4 * ((i_) - 2) + 1) + 2), (v_).z, (v_).w); } while (0)
#define G2_WX_K(par_) do { _Pragma("unroll") for (int d_ = 0; d_ < 2; ++d_) { LAS unsigned char* Ld_ = lds + d_ * SC_TEAM; \
        LAS bf16_t* kd_ = (LAS bf16_t*)(Ld_ + G2_K0 + (par_) * (G2_K1 - G2_K0)) + srow * 136 + sq * 32; \
        _Pragma("unroll") for (int i_ = 0; i_ < 4; ++i_) G2_PUT(kd_, i_, kst[d_][i_]); \
        ((LAS float*)(Ld_ + G2_SC + (par_) * 512))[tt & 127] = scv[d_]; } } while (0)
#define G2_WX_T(tst, ast, ost) do { _Pragma("unroll") for (int d_ = 0; d_ < 2; ++d_) { LAS unsigned char* Ld_ = lds + d_ * SC_TEAM; \
        LAS bf16_t* td_ = (LAS bf16_t*)(Ld_ + G2_TB) + srow * 72 + (sq >> 1) * 32 + (sq & 1) * 4; LAS bf16_t* ad_ = (LAS bf16_t*)(Ld_ + G2_AT) + srow * 72 + (sq >> 1) * 32 + (sq & 1) * 4; \
        G2_PUT(td_, 0, tst[d_][0]); G2_PUT(td_, 1, tst[d_][1]); G2_PUT(ad_, 0, ast[d_][0]); G2_PUT(ad_, 1, ast[d_][1]); \
        *(LAS u32x4*)((LAS bf16_t*)(Ld_ + G2_VC) + srow * 72 + 32 + sq * 8) = ost[d_]; } } while (0)
#define G2_WY(vst) do { _Pragma("unroll") for (int d_ = 0; d_ < 2; ++d_) { LAS unsigned char* Ld_ = lds + d_ * SC_TEAM; \
        LAS bf16_t* qd_ = (LAS bf16_t*)(Ld_ + G2_QC) + srow * 136 + sq * 32; \
        _Pragma("unroll") for (int i_ = 0; i_ < 4; ++i_) G2_PUT(qd_, i_, qst[d_][i_]); \
        *(LAS u32x4*)((LAS bf16_t*)(Ld_ + G2_VC) + srow * 72 + sq * 8) = vst[d_]; } } while (0)
    if (loader) {
        u32x4 kst[2][4], qst[2][4], vsA[2], vsB[2], tsA[2][2], asA[2][2], osA[2], tsB[2][2], asB[2][2], osB[2]; float scv[2];
        G2_FX_K(0); G2_FY(0); G2_FV(0, vsA);
        G2_WX_K(0); G2_WY(vsA);
        G2_FX_T(0, tsA, asA, osA); asm volatile("" ::: "memory"); G2_FV(1, vsB); asm volatile("" ::: "memory"); G2_FX_T(1, tsB, asB, osB); asm volatile("" ::: "memory");
        G2_FX_K(1); G2_FY(1); G2_FV(2, vsA);
        asm volatile("s_waitcnt lgkmcnt(0)" ::: "memory");
        __syncthreads();
#pragma unroll 1
        for (int s = 0; s < NSTEP; s += 2) {
            const int s2 = G2_CLAMP(s + 2), s3 = G2_CLAMP(s + 3), s4 = G2_CLAMP(s + 4);
            G2_WX_T(tsA, asA, osA);
            G2_FX_T(s2, tsA, asA, osA);
            asm volatile("s_waitcnt lgkmcnt(0)" ::: "memory");
            __syncthreads();
            G2_WX_K((s + 1) & 1); G2_WY(vsB);
            G2_FX_K(s2); G2_FY(s2); G2_FV(s3, vsB);
            asm volatile("s_waitcnt lgkmcnt(0)" ::: "memory");
            __syncthreads();
            G2_WX_T(tsB, asB, osB);
            G2_FX_T(s3, tsB, asB, osB);
            asm volatile("s_waitcnt lgkmcnt(0)" ::: "memory");
            __syncthreads();
            G2_WX_K(s & 1); G2_WY(vsA);
            G2_FX_K(s3); G2_FY(s3); G2_FV(s4, vsA);
            asm volatile("s_waitcnt lgkmcnt(0)" ::: "memory");
            __syncthreads();
        }
    } else {
    f32x4 accS[8];
#pragma unroll
    for (int i = 0; i < 8; ++i) accS[i] = (f32x4){0.f, 0.f, 0.f, 0.f};
    __syncthreads();
    const size_t ocol = (size_t)h * 128 + dvq * 32 + tw * 16 + 4 * fq;
    for (int s = 0; s < NSTEP; ++s) {
        const bool isx = s >= 4; const int g = chain_chunk(b, dir, s);
        const bool second = s >= XSTEP;
        const LAS bf16_t* Kc = (const LAS bf16_t*)(L + G2_K0 + (s & 1) * (G2_K1 - G2_K0)); const LAS float* SC = (const LAS float*)(L + G2_SC + (s & 1) * 512);
        bf16x8 Sf[4];
#pragma unroll
        for (int kk = 0; kk < 4; ++kk) Sf[kk] = pack8f(accS[2 * kk], accS[2 * kk + 1]);
        f32x4 aR[4], aQ[4];
#pragma unroll
        for (int mt = 0; mt < 4; ++mt) { aR[mt] = (f32x4){0.f, 0.f, 0.f, 0.f}; aQ[mt] = (f32x4){0.f, 0.f, 0.f, 0.f}; }
        { bf16x8 kfb[2][4], qfb[2][4];
#pragma unroll
            for (int mt = 0; mt < 4; ++mt) { kfb[0][mt] = *(const LAS bf16x8*)(Kc + (16 * mt + fr) * 136 + 8 * fq); if (isx) qfb[0][mt] = *(const LAS bf16x8*)(Qc + (16 * mt + fr) * 136 + 8 * fq); }
#pragma unroll
            for (int kk = 0; kk < 4; ++kk) {
                if (kk + 1 < 4) {
#pragma unroll
                    for (int mt = 0; mt < 4; ++mt) { kfb[(kk + 1) & 1][mt] = *(const LAS bf16x8*)(Kc + (16 * mt + fr) * 136 + 32 * (kk + 1) + 8 * fq); if (isx) qfb[(kk + 1) & 1][mt] = *(const LAS bf16x8*)(Qc + (16 * mt + fr) * 136 + 32 * (kk + 1) + 8 * fq); } }
#pragma unroll
                for (int mt = 0; mt < 4; ++mt) { aR[mt] = MFMA16(kfb[kk & 1][mt], Sf[kk], aR[mt]); if (isx) aQ[mt] = MFMA16(Sf[kk], qfb[kk & 1][mt], aQ[mt]); } } }
        bf16x8 Rf[2];
        { f32x4 r[4];
#pragma unroll
            for (int h2 = 0; h2 < 2; ++h2) { const LAS unsigned char* va = (const LAS unsigned char*)(Vc + (32 * h2 + 8 * fq + (fr >> 2)) * 72 + 16 * tw + 4 * (fr & 3));
                const bf16x8 vf = cat8(lds_tr4(va), lds_tr4(va + 4 * 72 * 2));
#pragma unroll
                for (int e = 0; e < 2; ++e) { const int mt = 2 * h2 + e; const f32x4 eg4 = *(const LAS f32x4*)(SC + 16 * mt + 4 * fq);
                    bf16x8 es;
#pragma unroll
                    for (int j = 0; j < 8; ++j) es[j] = (8 * fq + j == 16 * e + fr) ? (short)0x3F80 : (short)0;
                    const f32x4 vA = MFMA16(es, vf, ((f32x4){0.f, 0.f, 0.f, 0.f})); r[mt] = vA - eg4 * aR[mt]; } }
            Rf[0] = pack8f(r[0], r[1]); Rf[1] = pack8f(r[2], r[3]); }
        __syncthreads();
        f32x4 aV[4];
#pragma unroll
        for (int mt = 0; mt < 4; ++mt) { aV[mt] = (f32x4){0.f, 0.f, 0.f, 0.f};
#pragma unroll
            for (int kk = 0; kk < 2; ++kk) if (kk <= (mt >> 1)) { const bf16x8 tf = *(const LAS bf16x8*)(Tbc + (16 * mt + fr) * 72 + 32 * kk + 8 * fq); aV[mt] = MFMA16(tf, Rf[kk], aV[mt]); } }
        bf16x8 VNf[2], VSf[2];
        { f32x4 sv[4];
#pragma unroll
            for (int mt = 0; mt < 4; ++mt) { const f32x4 et4 = *(const LAS f32x4*)(SC + 64 + 16 * mt + 4 * fq); sv[mt] = et4 * aV[mt]; }
            VNf[0] = pack8f(aV[0], aV[1]); VNf[1] = pack8f(aV[2], aV[3]); VSf[0] = pack8f(sv[0], sv[1]); VSf[1] = pack8f(sv[2], sv[3]); }
        u32x2 oprev[4];
        if (s == XSTEP) {
#pragma unroll
            for (int mt = 0; mt < 4; ++mt) oprev[mt] = *(const u32x2*)(O + (size_t)chunk_row(g, dir, 16 * mt + fr) * 1024 + ocol);
        } else if (second) {
#pragma unroll
            for (int mt = 0; mt < 4; ++mt) oprev[mt] = *(const LAS u32x2*)(Vc + (16 * mt + fr) * 72 + 32 + 16 * tw + 4 * fq); }
        if (isx) {
#pragma unroll
            for (int mt = 0; mt < 4; ++mt) { const float egl = SC[16 * mt + fr]; f32x4 o = aQ[mt] * egl;
#pragma unroll
                for (int kk = 0; kk < 2; ++kk) if (kk <= (mt >> 1)) { const bf16x8 af = *(const LAS bf16x8*)(Atc + (16 * mt + fr) * 72 + 32 * kk + 8 * fq); o = MFMA16(VNf[kk], af, o); }
                if (second) o = o + bf4_to_f32(make_uint2(oprev[mt].x, oprev[mt].y));
                *(u32x2*)(O + (size_t)chunk_row(g, dir, 16 * mt + fr) * 1024 + ocol) = pack4(o); } }
        { const float gt = SC[63];
#pragma unroll
            for (int md = 0; md < 8; ++md) accS[md] = accS[md] * gt; }
#pragma unroll
        for (int kk = 0; kk < 2; ++kk) { bf16x8 ktf[8];
#pragma unroll
            for (int md = 0; md < 8; ++md) { const LAS unsigned char* ka = (const LAS unsigned char*)(Kc + (32 * kk + 4 * fq + (fr >> 2)) * 136 + (md >> 1) * 32 + (2 * (fr & 3) + (md & 1)) * 4);
                ktf[md] = cat8(lds_tr4(ka), lds_tr4(ka + 16 * 136 * 2)); }
#pragma unroll
            for (int md = 0; md < 8; ++md) accS[md] = MFMA16(ktf[md], VSf[kk], accS[md]); }
        __syncthreads();
    }
    }
#undef G2_CLAMP
#undef G2_FX_K
#undef G2_FX_T
#undef G2_FY
#undef G2_FV
#undef G2_PUT
#undef G2_WX_K
#undef G2_WX_T
#undef G2_WY
}

constexpr int M2_K0 = 0, M2_K1 = 17408, M2_QC = 34816, M2_VV = 52224, M2_P = 61440, M2_OP = 70656, M2_SC = 75776, M2_END = 78336;
static_assert(M2_END <= SC_TEAM, "ml2 lds");
__device__ __forceinline__ void ml_scan2(const P& p, int n, LAS unsigned char* lds) {
    const bf16_t* ml = (const bf16_t*)(p.ws + WS_ML); const float* MLS = (const float*)(p.ws + WS_MLS); bf16_t* HM = (bf16_t*)p.out + (size_t)MX * 1024;
    const int tid = threadIdx.x, lane = tid & 63, wid = tid >> 6, tt = tid & 255, fr = lane & 15, fq = lane >> 4;
    const bool loader = wid >= 4;
    const int dir = loader ? 0 : (wid >> 1), tw = wid & 1;
    const int bh = n >> 3, dv8 = n & 7, b = bh >> 2, h = bh & 3, chain = bh * 2 + dir;
    LAS unsigned char* L = lds + dir * SC_TEAM;
    LAS bf16_t* Qc = (LAS bf16_t*)(L + M2_QC); LAS bf16_t* VV = (LAS bf16_t*)(L + M2_VV); LAS bf16_t* Pc = (LAS bf16_t*)(L + M2_P); LAS bf16_t* OPc = (LAS bf16_t*)(L + M2_OP);
    const int srow = tt >> 2, sq = tt & 3;
#define M2_CLAMP(s_) ((s_) < NSTEP ? (s_) : NSTEP - 1)
#define M2_FX_K(s_) do { _Pragma("unroll") for (int d_ = 0; d_ < 2; ++d_) { const int g_ = chain_chunk(b, d_, (s_)); const float* sc_ = MLS + ((size_t)(bh * 2 + d_) * NSTEP + (s_)) * 384; \
        const size_t rr_ = (size_t)h * MT + chunk_row(g_, d_, srow); \
        _Pragma("unroll") for (int i_ = 0; i_ < 4; ++i_) kst[d_][i_] = *(const u32x4*)(ml + (size_t)4 * MT * 128 + rr_ * 128 + sq * 32 + 8 * i_); \
        scv[d_] = sc_[tt]; wt2[d_] = sc_[256 + (tt & 63)]; } } while (0)
#define M2_FX_T(s_) do { _Pragma("unroll") for (int d_ = 0; d_ < 2; ++d_) { const int g_ = chain_chunk(b, d_, (s_)); const float* sc_ = MLS + ((size_t)(bh * 2 + d_) * NSTEP + (s_)) * 384; \
        const size_t rr_ = (size_t)h * MT + chunk_row(g_, d_, srow); \
        vst[d_] = *(const u32x4*)(ml + (size_t)8 * MT * 128 + rr_ * 256 + dv8 * 32 + sq * 8); wtv[d_] = sc_[256 + srow]; \
        const int go_ = g_ < 512 ? g_ : 511; ost[d_] = *(const u32x4*)(HM + (size_t)chunk_row(go_, d_, srow) * 1024 + h * 256 + dv8 * 32 + sq * 8); } } while (0)
#define M2_FY(s_) do { _Pragma("unroll") for (int d_ = 0; d_ < 2; ++d_) { const int g_ = chain_chunk(b, d_, (s_)); \
        const size_t rr_ = (size_t)h * MT + chunk_row(g_, d_, srow); \
        _Pragma("unroll") for (int i_ = 0; i_ < 4; ++i_) qst[d_][i_] = *(const u32x4*)(ml + rr_ * 128 + sq * 32 + 8 * i_); } } while (0)
#define M2_PUT(dst_, i_, v_) do { LDS_PUT64((dst_), 8 * (((i_) < 2) ? 4 * (i_) : 4 * ((i_) - 2) + 1), (v_).x, (v_).y); LDS_PUT64((dst_), 8 * ((((i_) < 2) ? 4 * (i_) : 4 * ((i_) - 2) + 1) + 2), (v_).z, (v_).w); } while (0)
#define M2_WX_K(par_) do { _Pragma("unroll") for (int d_ = 0; d_ < 2; ++d_) { LAS unsigned char* Ld_ = lds + d_ * SC_TEAM; \
        LAS bf16_t* kd_ = (LAS bf16_t*)(Ld_ + M2_K0 + (par_) * (M2_K1 - M2_K0)) + srow * 136 + sq * 32; \
        _Pragma("unroll") for (int i_ = 0; i_ < 4; ++i_) M2_PUT(kd_, i_, kst[d_][i_]); \
        LAS float* Sd_ = (LAS float*)(Ld_ + M2_SC + (par_) * 1280); Sd_[tt] = scv[d_]; Sd_[256 + (tt & 63)] = wt2[d_]; } } while (0)
#define M2_WX_T() do { _Pragma("unroll") for (int d_ = 0; d_ < 2; ++d_) { LAS unsigned char* Ld_ = lds + d_ * SC_TEAM; LAS bf16_t* Vd_ = (LAS bf16_t*)(Ld_ + M2_VV) + srow * 72 + sq * 8; \
        *(LAS u32x4*)Vd_ = vst[d_]; \
        { const f32x4 a_ = bf4_to_f32(make_uint2(vst[d_].x, vst[d_].y)) * wtv[d_], b_ = bf4_to_f32(make_uint2(vst[d_].z, vst[d_].w)) * wtv[d_]; const u32x2 pa_ = pack4(a_), pb_ = pack4(b_); \
          *(LAS u32x4*)(Vd_ + 32) = mk4(pa_.x, pa_.y, pb_.x, pb_.y); } \
        *(LAS u32x4*)((LAS bf16_t*)(Ld_ + M2_OP) + srow * 40 + sq * 8) = ost[d_]; } } while (0)
#define M2_WY() do { _Pragma("unroll") for (int d_ = 0; d_ < 2; ++d_) { LAS unsigned char* Ld_ = lds + d_ * SC_TEAM; \
        LAS bf16_t* qd_ = (LAS bf16_t*)(Ld_ + M2_QC) + srow * 136 + sq * 32; \
        _Pragma("unroll") for (int i_ = 0; i_ < 4; ++i_) M2_PUT(qd_, i_, qst[d_][i_]); } } while (0)
    if (loader) {
        u32x4 kst[2][4], qst[2][4], vst[2], ost[2]; float scv[2], wtv[2], wt2[2];
        M2_FX_K(0); M2_FY(0);
        M2_WX_K(0); M2_WY();
        M2_FX_T(0); M2_FX_K(1); asm volatile("" ::: "memory"); M2_FY(1);
        asm volatile("s_waitcnt lgkmcnt(0)" ::: "memory");
        __syncthreads();
#pragma unroll 1
        for (int s = 0; s < NSTEP; ++s) {
            const int s1 = M2_CLAMP(s + 1), s2 = M2_CLAMP(s + 2);
            M2_WX_T();
            M2_FX_T(s1);
            asm volatile("s_waitcnt lgkmcnt(0)" ::: "memory");
            __syncthreads();
            M2_WX_K((s + 1) & 1); M2_WY();
            M2_FX_K(s2); M2_FY(s2);
            asm volatile("s_waitcnt lgkmcnt(0)" ::: "memory");
            __syncthreads();
        }
    } else {
    f32x4 accC[8], accN[8];
#pragma unroll
    for (int i = 0; i < 8; ++i) { accC[i] = (f32x4){0.f, 0.f, 0.f, 0.f}; accN[i] = (f32x4){0.f, 0.f, 0.f, 0.f}; }
    float dec = MLS[((size_t)chain * NSTEP + 0) * 384 + 320], n_dec = 0.f;
    __syncthreads();
    const size_t ocol = (size_t)h * 256 + dv8 * 32 + tw * 16 + 4 * fq;
    const short one_or_zero = (fr == 0) ? (short)0x3F80 : (short)0;
    for (int s = 0; s < NSTEP; ++s) {
        const bool isx = s >= 4, more = s + 1 < NSTEP; const int g = chain_chunk(b, dir, s);
        const bool second = s >= XSTEP;
        const LAS bf16_t* Kc = (const LAS bf16_t*)(L + M2_K0 + (s & 1) * (M2_K1 - M2_K0)); const LAS float* SC = (const LAS float*)(L + M2_SC + (s & 1) * 1280);
        if (more) n_dec = MLS[((size_t)chain * NSTEP + (s + 1)) * 384 + 320];
        f32x4 num[4], den[4];
        if (isx) {
#define M2_PFIN(a_, rt_, st_) do { const int l_ = 16 * (rt_) + fr; const float bl_ = SC[l_]; const f32x4 cs4_ = *(const LAS f32x4*)(SC + 64 + 16 * (st_) + 4 * fq); \
            _Pragma("unroll") for (int q4 = 0; q4 < 4; ++q4) { const int sx_ = 16 * (st_) + 4 * fq + q4; (a_)[q4] = sx_ <= l_ ? (a_)[q4] * __expf(bl_ + cs4_[q4]) : 0.f; } \
            *(LAS u32x2*)(Pc + l_ * 72 + 16 * (st_) + 4 * fq) = pack4(a_); } while (0)
#define M2_LDF(dst_, base_, row_) do { _Pragma("unroll") for (int kk = 0; kk < 4; ++kk) (dst_)[kk] = *(const LAS bf16x8*)((base_) + (16 * (row_) + fr) * 136 + 32 * kk + 8 * fq); } while (0)
#define M2_MM(acc_, kf_, qf_) do { _Pragma("unroll") for (int kk = 0; kk < 4; ++kk) (acc_) = MFMA16((kf_)[kk], (qf_)[kk], (acc_)); } while (0)
            bf16x8 Cf[4], Nf[4];
#pragma unroll
            for (int kk = 0; kk < 4; ++kk) { Cf[kk] = pack8f(accC[2 * kk], accC[2 * kk + 1]); Nf[kk] = pack8f(accN[2 * kk], accN[2 * kk + 1]); }
#pragma unroll
            for (int mt = 3; mt >= 0; --mt) { bf16x8 qf[4]; M2_LDF(qf, Qc, mt);
                num[mt] = (f32x4){0.f, 0.f, 0.f, 0.f}; den[mt] = (f32x4){0.f, 0.f, 0.f, 0.f};
#pragma unroll
                for (int kk = 0; kk < 4; ++kk) { num[mt] = MFMA16(Cf[kk], qf[kk], num[mt]); den[mt] = MFMA16(Nf[kk], qf[kk], den[mt]); }
                if (tw == ((mt == 1 || mt == 2) ? 1 : 0)) {
#pragma unroll
                    for (int st = 0; st <= mt; ++st) { bf16x8 kA[4]; f32x4 a0 = {0.f, 0.f, 0.f, 0.f}; M2_LDF(kA, Kc, st); M2_MM(a0, kA, qf); M2_PFIN(a0, mt, st); }
                    if (mt == 0) *(LAS u32x2*)(Pc + fr * 72 + 16 + 4 * fq) = (u32x2){0u, 0u};
                    if (mt == 2) *(LAS u32x2*)(Pc + (32 + fr) * 72 + 48 + 4 * fq) = (u32x2){0u, 0u};
                }
                const float it = SC[128 + 16 * mt + fr];
                num[mt] = num[mt] * it; den[mt] = den[mt] * it; }
#undef M2_PFIN
#undef M2_LDF
#undef M2_MM
        }
        __syncthreads();
        if (isx) {
            u32x2 oprev[4];
            if (s == XSTEP) {
#pragma unroll
                for (int mt = 0; mt < 4; ++mt) oprev[mt] = *(const u32x2*)(HM + (size_t)chunk_row(g, dir, 16 * mt + fr) * 1024 + ocol);
            } else if (second) {
#pragma unroll
                for (int mt = 0; mt < 4; ++mt) oprev[mt] = *(const LAS u32x2*)(OPc + (16 * mt + fr) * 40 + 16 * tw + 4 * fq); }
            bf16x8 vAf[2], onesA;
#pragma unroll
            for (int j = 0; j < 8; ++j) onesA[j] = one_or_zero;
#pragma unroll
            for (int kk = 0; kk < 2; ++kk) { const LAS unsigned char* va = (const LAS unsigned char*)(VV + (32 * kk + 8 * fq + (fr >> 2)) * 72 + 16 * tw + 4 * (fr & 3)); vAf[kk] = cat8(lds_tr4(va), lds_tr4(va + 4 * 72 * 2)); }
#pragma unroll
            for (int mt = 0; mt < 4; ++mt) {
                f32x4 nm = num[mt], dn4 = den[mt];
#pragma unroll
                for (int kk = 0; kk < 2; ++kk) if (kk <= (mt >> 1)) { const bf16x8 pf = *(const LAS bf16x8*)(Pc + (16 * mt + fr) * 72 + 32 * kk + 8 * fq); nm = MFMA16(vAf[kk], pf, nm); dn4 = MFMA16(onesA, pf, dn4); }
                const float dsum = __shfl(dn4[0], fr);
                const float dn = fmaxf(fabsf(dsum), SC[192 + 16 * mt + fr]);
                f32x4 o = nm * __builtin_amdgcn_rcpf(dn);
                if (second) o = o + bf4_to_f32(make_uint2(oprev[mt].x, oprev[mt].y));
                *(u32x2*)(HM + (size_t)chunk_row(g, dir, 16 * mt + fr) * 1024 + ocol) = pack4(o);
            }
        }
        {
#pragma unroll
            for (int md = 0; md < 8; ++md) { accC[md] = accC[md] * dec; accN[md] = accN[md] * dec; }
#pragma unroll
            for (int kk = 0; kk < 2; ++kk) { const LAS unsigned char* wa = (const LAS unsigned char*)(VV + (32 * kk + 8 * fq + (fr >> 2)) * 72 + 32 + 16 * tw + 4 * (fr & 3));
                const bf16x8 vwf = cat8(lds_tr4(wa), lds_tr4(wa + 4 * 72 * 2));
                const f32x4 w0 = *(const LAS f32x4*)(SC + 256 + 32 * kk + 8 * fq), w1 = *(const LAS f32x4*)(SC + 256 + 32 * kk + 8 * fq + 4);
                bf16x8 wtf = pack8f(w0, w1); if (fr != 0) wtf = (bf16x8){0, 0, 0, 0, 0, 0, 0, 0};
                bf16x8 ktf[8];
#pragma unroll
                for (int md = 0; md < 8; ++md) { const LAS unsigned char* ka = (const LAS unsigned char*)(Kc + (32 * kk + 8 * fq + (fr >> 2)) * 136 + (md >> 1) * 32 + (2 * (fr & 3) + (md & 1)) * 4);
                    ktf[md] = cat8(lds_tr4(ka), lds_tr4(ka + 4 * 136 * 2)); }
#pragma unroll
                for (int md = 0; md < 8; ++md) { accC[md] = MFMA16(ktf[md], vwf, accC[md]); accN[md] = MFMA16(ktf[md], wtf, accN[md]); } }
        }
        __syncthreads();
        dec = n_dec;
    }
    }
#undef M2_CLAMP
#undef M2_FX_K
#undef M2_FX_T
#undef M2_FY
#undef M2_PUT
#undef M2_WX_K
#undef M2_WX_T
#undef M2_WY
}

__device__ __forceinline__ void late_weights(const P& p, int gw, int ngw, LAS unsigned char* lds) {
    bf16_t* WINO = (bf16_t*)(p.ws + WS_WINO); bf16_t* WBG = (bf16_t*)(p.ws + WS_WBG); bf16_t* WBM = (bf16_t*)(p.ws + WS_WBM); bf16_t* WOUT = (bf16_t*)(p.ws + WS_WOUT);
    bf16_t* WUP = (bf16_t*)(p.ws + WS_WUP); bf16_t* WDOWN = (bf16_t*)(p.ws + WS_WDOWN);
    constexpr int I0 = 16 * 64, I1 = I0 + 256, I2 = I1 + 256, I3 = I2 + 256, I4 = I3 + 16 * 88, I5 = I4 + 44 * 16;
    LAS float* scr = (LAS float*)(lds + (threadIdx.x >> 6) * 16896); const int lane_ = threadIdx.x & 63;
    for (int it = gw; it < I5; it += ngw) {
        if (it < I0) wt_item(p.w_in, D, NIN, 4096, WINO, MapOff{NST}, scr, it, lane_);
        else if (it < I1) wt_item(p.w_bg, D, D, D, WBG, MapOff{0}, scr, it - I0, lane_);
        else if (it < I2) wt_item(p.w_bm, D, D, D, WBM, MapOff{0}, scr, it - I1, lane_);
        else if (it < I3) wt_item(p.w_out, D, D, D, WOUT, MapOff{0}, scr, it - I2, lane_);
        else if (it < I4) wt_item(p.w_up, D, 2 * DFF, 2 * DFF, WUP, MapUp{}, scr, it - I3, lane_);
        else wt_item(p.w_down, DFF, D, D, WDOWN, MapOff{0}, scr, it - I4, lane_); }
}

__device__ __forceinline__ void phase_scan(const P& p, int bid, int nblk, LAS unsigned char* lds, float* smem) {
#pragma unroll 1
    for (int vb = bid; vb < 256; vb += nblk) { const int xcd = vb & 7, li = vb >> 3; if (li < 16) { gdn_scan2(p, xcd * 16 + li, lds); __syncthreads(); } }
    if (nblk == 256 && (bid >> 3) < 16) {
        if (threadIdx.x == 0) { unsigned* cnt = (unsigned*)(p.ws + WS_CTL + 49152);
            __hip_atomic_fetch_add(cnt, 1u, __ATOMIC_RELEASE, __HIP_MEMORY_SCOPE_AGENT);
            while (__hip_atomic_load(cnt, __ATOMIC_ACQUIRE, __HIP_MEMORY_SCOPE_AGENT) < 128u) __builtin_amdgcn_s_sleep(16); }
        __syncthreads();
        const int gi = (bid & 7) * 16 + (bid >> 3);
        late_weights(p, gi * NWAVES + (int)(threadIdx.x >> 6), 128 * NWAVES, lds);
        __syncthreads();
    }
#pragma unroll 1
    for (int vb = bid; vb < 256; vb += nblk) { const int xcd = vb & 7, li = vb >> 3; if (li >= 16) { ml_scan2(p, xcd * 16 + (li - 16), lds); __syncthreads(); } }
    if (nblk == 256 && (bid >> 3) >= 16) { phase_shw(p, (bid & 7) * 16 + ((bid >> 3) - 16), 128, smem); __syncthreads(); }
}

#define XB_TMO      128
#define XB_XCNT(j)  (256  + 64 * (j))
#define XB_XSUB(j)  (1280 + 64 * (j))
#define XB_XGEN(j)  (2304 + 64 * (j))
#define XB_TOP      3328
#define XB_TOPGEN   3392
#define XCD_BAR_WORDS 3456
#define XB_SPIN_CAP (1u << 18)

__device__ __forceinline__ unsigned xb_ld(unsigned* p)              { return __hip_atomic_load(p, __ATOMIC_RELAXED, __HIP_MEMORY_SCOPE_AGENT); }
__device__ __forceinline__ unsigned xb_add(unsigned* p, unsigned v) { return __hip_atomic_fetch_add(p, v, __ATOMIC_RELAXED, __HIP_MEMORY_SCOPE_AGENT); }
__device__ __forceinline__ unsigned xb_xcc_id() { return (unsigned)__builtin_amdgcn_s_getreg((3 << 11) | 20) & 0xFu; }
#define XB_SPIN(cond, bar) do { unsigned _sp = 0; while (cond) { __builtin_amdgcn_s_sleep(1); \
    if ((++_sp & 255u) == 0u) { if (xb_ld(&(bar)[XB_TMO])) break; if (_sp > XB_SPIN_CAP) { atomicAdd(&(bar)[XB_TMO], 1u); break; } } } } while (0)

struct XcdBarrier {
    unsigned* bar; unsigned x;
    volatile LAS unsigned* st;
};

__device__ __forceinline__ XcdBarrier xcd_barrier_post(unsigned* bar, volatile LAS unsigned* st) {
    XcdBarrier b; b.bar = bar; b.x = xb_xcc_id(); b.st = st;
    if (threadIdx.x == 0) (void)xb_add(&bar[XB_XCNT(b.x)], 1u);
    return b;
}
__device__ __forceinline__ void xcd_barrier_complete(unsigned* bar, unsigned x, unsigned& nloc, unsigned& nx) {
    const unsigned G = gridDim.x * gridDim.y * gridDim.z;
    unsigned sum, cnt, mine, sp = 0u;
    for (;;) {
        sum = 0u; cnt = 0u; mine = 0u;
#pragma unroll
        for (unsigned j = 0; j < 16; ++j) { const unsigned c = xb_ld(&bar[XB_XCNT(j)]); sum += c; cnt += (c > 0u) ? 1u : 0u; mine = (j == x) ? c : mine; }
        if (sum == G) break;
        __builtin_amdgcn_s_sleep(1);
        if ((++sp & 255u) == 0u) { if (xb_ld(&bar[XB_TMO])) break; if (sp > XB_SPIN_CAP) { atomicAdd(&bar[XB_TMO], 1u); break; } }
    }
    nloc = mine > 0u ? mine : 1u; nx = cnt > 0u ? cnt : 1u;
}

__device__ __forceinline__ void xcd_barrier(const XcdBarrier& b) {
    asm volatile("s_waitcnt vmcnt(0)" ::: "memory");
    __syncthreads();
    if (threadIdx.x == 0) {
        unsigned* bar = b.bar;
        __builtin_amdgcn_s_waitcnt(0);
        unsigned nloc = b.st[0], nx = b.st[1];
        if (nloc == 0u) { xcd_barrier_complete(bar, b.x, nloc, nx); b.st[0] = nloc; b.st[1] = nx; }
        const unsigned old = xb_add(&bar[XB_XSUB(b.x)], 1u);
        const unsigned gen = old / nloc;
        if (old + 1u == (gen + 1u) * nloc) {
            __builtin_amdgcn_fence(__ATOMIC_RELEASE, "agent");
            asm volatile("s_waitcnt vmcnt(0)" ::: "memory");
            const unsigned og = xb_add(&bar[XB_TOP], 1u);
            const unsigned tg = og / nx;
            if (og + 1u == (tg + 1u) * nx) xb_add(&bar[XB_TOPGEN], 1u);
            else XB_SPIN(xb_ld(&bar[XB_TOPGEN]) == tg, bar);
            __builtin_amdgcn_fence(__ATOMIC_ACQUIRE, "agent");
            xb_add(&bar[XB_XGEN(b.x)], 1u);
            asm volatile("s_waitcnt vmcnt(0)" ::: "memory");
        } else {
            XB_SPIN(xb_ld(&bar[XB_XGEN(b.x)]) == gen, bar);
            __builtin_amdgcn_fence(__ATOMIC_ACQUIRE, "agent");
            asm volatile("s_waitcnt vmcnt(0)" ::: "memory");
        }
    }
    __syncthreads();
}

template <class E>
__device__ __forceinline__ void run_gemm(LAS unsigned char* lds, const bf16_t* A, const bf16_t* Bt, int M, int N, int K, const E& e) {
    pg8::Gemm g{A, Bt, M, N, K}; pg8::StaticOrder S; S.init(M, N, (int)gridDim.x, (int)blockIdx.x);
    pg8::gemm_phase<E, pg8::StaticOrder, true, true>(lds, g, S, e);
}

__global__ void __launch_bounds__(NTHREADS, 2) mega(Args args) {
    extern __shared__ __attribute__((aligned(16))) unsigned char lds_raw[];
    LAS unsigned char* lds = (LAS unsigned char*)lds_raw;
    float* smem = (float*)lds_raw;
    const P& p = args.p;
    unsigned char* ws = p.ws;
    const int bid = blockIdx.x, nblk = gridDim.x;
    const int gw = bid * NWAVES + (threadIdx.x >> 6), ngw = nblk * NWAVES;
    bf16_t* HX = (bf16_t*)(ws + WS_HX); bf16_t* QKV = (bf16_t*)(ws + WS_QKV); bf16_t* ML = (bf16_t*)(ws + WS_ML);
    float* GATES = (float*)(ws + WS_GATES); bf16_t* HALO = (bf16_t*)(ws + WS_HALO); float* MOD = (float*)(ws + WS_MOD);
    bf16_t* O = (bf16_t*)p.out; bf16_t* HM = O + (size_t)MX * 1024;
    bf16_t* HXB = (bf16_t*)(ws + WS_HXB); bf16_t* Z = (bf16_t*)(ws + WS_Z); bf16_t* TMP = (bf16_t*)(ws + WS_TMP); bf16_t* MERGED = (bf16_t*)(ws + WS_MERGED);
    bf16_t* HX2 = (bf16_t*)(ws + WS_HX2); bf16_t* U = (bf16_t*)(ws + WS_U); bf16_t* ACT = (bf16_t*)(ws + WS_ACT);
    bf16_t* WINS = (bf16_t*)(ws + WS_WINS); bf16_t* WINO = (bf16_t*)(ws + WS_WINO); bf16_t* WBG = (bf16_t*)(ws + WS_WBG); bf16_t* WBM = (bf16_t*)(ws + WS_WBM);
    bf16_t* WOUT = (bf16_t*)(ws + WS_WOUT); bf16_t* WUP = (bf16_t*)(ws + WS_WUP); bf16_t* WDOWN = (bf16_t*)(ws + WS_WDOWN);
    const int lo = args.ph_lo, hi = args.ph_hi;
    volatile LAS unsigned* misc = (volatile LAS unsigned*)(lds + LDS_MISC);
    if (threadIdx.x < 32) misc[threadIdx.x] = 0u;
    __syncthreads();
    XcdBarrier xbar = xcd_barrier_post((unsigned*)(ws + WS_CTL), misc);
#define IN(k) (lo <= (k) && (k) < hi)
#define SEAM(k) do { if (IN(k)) { GRID_SYNC(); } } while (0)
#define GRID_SYNC() xcd_barrier(xbar)
    if (IN(0)) { phase_mod(p, bid, nblk, smem); __syncthreads(); wt_convert(p.w_in, D, NIN, NSTP, WINS, MapInS{}, lds, gw, ngw); } SEAM(0);
    if (IN(1)) { phase_norm(p, 1, 0, MT, HX, bid, nblk); } SEAM(1);
    if (IN(2)) { run_gemm(lds, HX, WINS, MT, NSTP, D, epi::Zs{QKV, ML, GATES, HALO}); } SEAM(2);
    if (IN(3)) { phase_prep2(p, bid, nblk, lds); } SEAM(3);
    if (IN(4)) { phase_scan(p, bid, nblk, lds, smem); } SEAM(4);
    if (IN(5)) { phase_norm(p, 1, 0, MX, HXB, bid, nblk);
                 { float* rowss_ = (float*)(ws + WS_ROWSS); for (int i = bid * NTHREADS + (int)threadIdx.x; i < MX; i += nblk * NTHREADS) rowss_[i] = 0.f; }
                 if (nblk != 256) { phase_shw(p, bid, nblk, smem); __syncthreads(); late_weights(p, gw, ngw, lds); } } SEAM(5);
    if (IN(6)) { run_gemm(lds, HXB, WINO, MX, 4096, D, epi::Zo{Z, O, HM, p.gdn_norm_w, p.ml_norm_w, (LAS float*)(lds + 131072)}); } SEAM(6);
    if (IN(8)) { run_gemm(lds, O, WBG, MX, D, D, epi::Br1{Z, TMP}); asm volatile("s_waitcnt vmcnt(0)" ::: "memory"); __syncthreads(); }
    if (IN(9)) { run_gemm(lds, HM, WBM, MX, D, D, epi::Br2{Z, TMP, MERGED}); } SEAM(9);
    if (IN(10)) { run_gemm(lds, MERGED, WOUT, MX, D, D, epi::ResN{p.x, MOD, p.out, HX2, p.norm2_w, (float*)(ws + WS_ROWSS)}); } SEAM(10);
    if (IN(12)) { run_gemm(lds, HX2, WUP, MX, UPA_N, D, epi::Up{U, UPA_N, (const float*)(ws + WS_ROWSS), (const float*)(ws + WS_SHW), 0}); } SEAM(12);
    if (IN(13)) { phase_convact<8>(p, 0, UPA_C, bid, nblk, lds); } SEAM(13);
    if (IN(14)) { run_gemm(lds, HX2, WUP + (size_t)UPA_N * D, MX, UPB_N, D, epi::Up{U, UPB_N, (const float*)(ws + WS_ROWSS), (const float*)(ws + WS_SHW), UPA_N}); } SEAM(14);
    if (IN(15)) { phase_convact<8>(p, UPA_C, UPB_C, bid, nblk, lds); } SEAM(15);
    if (IN(16)) { run_gemm(lds, ACT, WDOWN, MX, D, DFF, epi::Res{p.out, MOD, 5, p.out}); } SEAM(16);
    if (IN(17)) { phase_final(p, bid, nblk); }
}

extern "C" void kernel_launch(void* const* d_in, const int* in_sizes, int n_in, void* d_out, int out_size, void* d_ws, size_t ws_size, hipStream_t stream) {
    static int grid = 0;
    if (grid == 0) {
        int dev = 0, cus = 0, per_cu = 0;
        (void)hipGetDevice(&dev); (void)hipDeviceGetAttribute(&cus, hipDeviceAttributeMultiprocessorCount, dev);
        (void)hipFuncSetAttribute((const void*)mega, hipFuncAttributeMaxDynamicSharedMemorySize, LDS_BYTES);
        (void)hipOccupancyMaxActiveBlocksPerMultiprocessor(&per_cu, (const void*)mega, NTHREADS, LDS_BYTES);
        if (per_cu < 1) per_cu = 1;
        if (per_cu > 1) per_cu = 1;
        grid = (cus > 0 ? cus : 256) * per_cu;
    }
    Args a{};
    const float** f = (const float**)&a.p;
    for (int i = 0; i < 23; ++i) f[i] = (const float*)d_in[i];
    a.p.out = (float*)d_out; a.p.ws = (unsigned char*)d_ws;
    a.ph_lo = 0; a.ph_hi = 18;
    (void)hipMemsetAsync((char*)d_ws + WS_CTL, 0, 65536, stream);
    void* args[] = {&a};
    hipError_t e = hipLaunchCooperativeKernel((const void*)mega, dim3(grid), dim3(NTHREADS), args, LDS_BYTES, stream);
    if (e != hipSuccess) fprintf(stderr, "cooperative launch failed: %s (grid %d)\n", hipGetErrorString(e), grid);
}
```
